# Optimizing an MI355X kernel written in HIP

```python
import numpy as np
import jax
import jax.numpy as jnp
from jax import lax

D_MODEL = 1024
BATCH = 8
SEQ = 4096
DEPTH = 1

RET_HEADS = 4
RET_DK = 128
RET_DV = 256
RET_CHUNK = 128
NSA_HEADS = 8
NSA_GROUPS = 2
NSA_HPG = NSA_HEADS // NSA_GROUPS
NSA_DH = 64
CMP_LEN = 32
CMP_STRIDE = 16
SLC_LEN = 64
SLC_TOPN = 16
WINDOW = 512
NSA_QBLOCK = 64
SEL_FORCE = 1.0e4
N_EXPERTS = 256
TOP_K = 8
N_EXPERT_GROUPS = 8
TOPK_GROUPS = 4
D_EXPERT = 256
D_SHARED = 256
ROUTED_SCALE = 2.5
MOE_BLOCK = 128
ROPE_THETA = 10000.0
LN_EPS = 1e-5
NEG_INF = -1.0e30

RET_QK_W = RET_HEADS * RET_DK
RET_V_W = RET_HEADS * RET_DV
NSA_Q_W = NSA_HEADS * NSA_DH
NSA_KV_W = NSA_GROUPS * NSA_DH
IN_SPLITS = (RET_QK_W, RET_QK_W, RET_V_W, RET_V_W,
             NSA_Q_W, NSA_KV_W, NSA_KV_W, NSA_KV_W, NSA_KV_W, NSA_KV_W, NSA_KV_W,
             NSA_HEADS * 3, D_MODEL, D_MODEL)
D_IN = sum(IN_SPLITS)

kernel_name = 'hybrid_retention_nsa_moe_block'


def _normalize(x32):
    mu = jnp.mean(x32, -1, keepdims=True)
    var = jnp.mean(jnp.square(x32 - mu), -1, keepdims=True)
    return (x32 - mu) * lax.rsqrt(var + LN_EPS)


def _layernorm(x, g, b):
    y = _normalize(x.astype(jnp.float32))
    return (y * g.astype(jnp.float32) + b.astype(jnp.float32)).astype(x.dtype)


def _modulate(x, shift, scale):
    y = _normalize(x.astype(jnp.float32))
    return (y * (1.0 + scale.astype(jnp.float32)) + shift.astype(jnp.float32)).astype(x.dtype)


def _rope(x, pos):
    half = x.shape[-1] // 2
    inv_freq = ROPE_THETA ** (-jnp.arange(half, dtype=jnp.float32) / half)
    ang = pos.astype(jnp.float32)[:, None] * inv_freq[None, :]
    cos = jnp.cos(ang)[None, :, None, :]
    sin = jnp.sin(ang)[None, :, None, :]
    x32 = x.astype(jnp.float32)
    x1, x2 = x32[..., :half], x32[..., half:]
    return jnp.concatenate([x1 * cos - x2 * sin, x2 * cos + x1 * sin], -1).astype(x.dtype)


def _masked_softmax(s, mask):
    s = jnp.where(mask, s.astype(jnp.float32), NEG_INF)
    return jnp.where(mask, jax.nn.softmax(s, axis=-1), 0.0)


def _split_cols(z, sizes):
    return jnp.split(z, list(np.cumsum(sizes)[:-1]), axis=-1)


def _retention(q, k, v, g):
    B, S, H, dk = q.shape
    dv = v.shape[-1]
    C = RET_CHUNK
    N = S // C
    log_gamma = jnp.log1p(-jnp.exp2(-5.0 - jnp.arange(H, dtype=jnp.float32)))
    i = jnp.arange(C, dtype=jnp.float32)
    diff = i[:, None] - i[None, :]
    decay = jnp.where(diff >= 0, jnp.exp(log_gamma[:, None, None] * jnp.maximum(diff, 0.0)), 0.0)
    qc = q.reshape(B, N, C, H, dk).astype(jnp.float32)
    kc = k.reshape(B, N, C, H, dk).astype(jnp.float32) * dk ** -0.5
    vc = v.reshape(B, N, C, H, dv).astype(jnp.float32)
    inner = jnp.einsum('bnhqk,bnkhe->bnqhe', jnp.einsum('bnqhd,bnkhd->bnhqk', qc, kc) * decay, vc)
    zeta = jnp.exp(log_gamma[None, :] * (C - 1.0 - i)[:, None])
    kv = jnp.einsum('bnkhd,bnkhe->bnhde', kc * zeta[:, :, None], vc)
    chunk_decay = jnp.exp(log_gamma * C)[:, None, None]

    def step(state, kv_n):
        return state * chunk_decay + kv_n, state

    _, prev = lax.scan(step, jnp.zeros((B, H, dk, dv), jnp.float32), jnp.moveaxis(kv, 1, 0))
    prev = jnp.moveaxis(prev, 0, 1)
    xi = jnp.exp(log_gamma[None, :] * (i + 1.0)[:, None])
    cross = jnp.einsum('bnqhd,bnhde->bnqhe', qc, prev) * xi[:, :, None]
    o = _normalize((inner + cross).reshape(B, S, H, dv)).reshape(B, S, H * dv)
    return (o * jax.nn.silu(g.astype(jnp.float32))).astype(g.dtype)


def _nsa(q, k_c, v_c, k_s, v_s, k_w, v_w, gates, pos, cmp_pos_k, cmp_pos_v, w_cmp_k, w_cmp_v):
    B, S, _ = q.shape
    G, HPG, dh = NSA_GROUPS, NSA_HPG, NSA_DH
    q = _rope(q.reshape(B, S, NSA_HEADS, dh), pos)
    k_c = _rope(k_c.reshape(B, S, G, dh), pos)
    k_s = _rope(k_s.reshape(B, S, G, dh), pos)
    k_w = _rope(k_w.reshape(B, S, G, dh), pos)
    v_c = v_c.reshape(B, S, G, dh)
    v_s = v_s.reshape(B, S, G, dh)
    v_w = v_w.reshape(B, S, G, dh)
    scale = dh ** -0.5
    n_cmp = (S - CMP_LEN) // CMP_STRIDE + 1
    cmp_start = np.arange(n_cmp) * CMP_STRIDE
    blk_idx = cmp_start[:, None] + np.arange(CMP_LEN)[None, :]
    k_cmp = jnp.einsum('bnlgd,lde->bnge', k_c[:, blk_idx] + cmp_pos_k[None, None, :, None, :], w_cmp_k)
    v_cmp = jnp.einsum('bnlgd,lde->bnge', v_c[:, blk_idx] + cmp_pos_v[None, None, :, None, :], w_cmp_v)
    cmp_last = jnp.asarray(cmp_start + CMP_LEN - 1, jnp.int32)
    n_slc = S // SLC_LEN
    n_sel = min(SLC_TOPN, n_slc)
    slc_start = np.arange(n_slc) * SLC_LEN
    overlap = jnp.asarray(((cmp_start[:, None] < slc_start[None, :] + SLC_LEN)
                           & (cmp_start[:, None] + CMP_LEN > slc_start[None, :])).astype(np.float32))
    k_blk = k_s.reshape(B, n_slc, SLC_LEN, G, dh).transpose(0, 3, 1, 2, 4)
    v_blk = v_s.reshape(B, n_slc, SLC_LEN, G, dh).transpose(0, 3, 1, 2, 4)
    b_ix = jnp.arange(B)[:, None, None, None]
    g_ix = jnp.arange(G)[None, :, None, None]
    slc_ids = jnp.arange(n_slc)
    k_pad = jnp.pad(k_w, ((0, 0), (WINDOW, 0), (0, 0), (0, 0)))
    v_pad = jnp.pad(v_w, ((0, 0), (WINDOW, 0), (0, 0), (0, 0)))
    QB = NSA_QBLOCK
    nb = S // QB
    q_blocks = jnp.moveaxis(q.reshape(B, nb, QB, G, HPG, dh), 1, 0)
    g_blocks = jnp.moveaxis(jax.nn.sigmoid(gates.astype(jnp.float32)).astype(q.dtype).reshape(B, nb, QB, G, HPG, 3), 1, 0)

    def block(args):
        qb, qx, gx = args
        t = qb * QB + jnp.arange(QB)
        p_c = _masked_softmax(jnp.einsum('bqghd,bngd->bghqn', qx, k_cmp) * scale, cmp_last[None, :] <= t[:, None])
        o_c = jnp.einsum('bghqn,bngd->bqghd', p_c.astype(v_cmp.dtype), v_cmp)
        imp = jnp.einsum('bghqn,nj->bgqj', p_c, overlap)
        cur = t // SLC_LEN
        forced = (slc_ids[None, :] == 0) | (slc_ids[None, :] == cur[:, None]) | (slc_ids[None, :] == cur[:, None] - 1)
        imp = jnp.where(forced, SEL_FORCE, imp)
        imp = jnp.where(slc_ids[None, :] * SLC_LEN > t[:, None], -SEL_FORCE, imp)
        _, sel = lax.top_k(imp, n_sel)
        k_sel = k_blk[b_ix, g_ix, sel].reshape(B, G, QB, n_sel * SLC_LEN, dh)
        v_sel = v_blk[b_ix, g_ix, sel].reshape(B, G, QB, n_sel * SLC_LEN, dh)
        k_pos = (sel[..., None] * SLC_LEN + jnp.arange(SLC_LEN)).reshape(B, G, QB, n_sel * SLC_LEN)
        p_s = _masked_softmax(jnp.einsum('bqghd,bgqkd->bghqk', qx, k_sel) * scale,
                              (k_pos <= t[None, None, :, None])[:, :, None])
        o_s = jnp.einsum('bghqk,bgqkd->bqghd', p_s.astype(v_sel.dtype), v_sel)
        k_win = lax.dynamic_slice_in_dim(k_pad, qb * QB, WINDOW + QB, axis=1)
        v_win = lax.dynamic_slice_in_dim(v_pad, qb * QB, WINDOW + QB, axis=1)
        w_pos = qb * QB - WINDOW + jnp.arange(WINDOW + QB)
        w_mask = (w_pos[None, :] <= t[:, None]) & (w_pos[None, :] > t[:, None] - WINDOW) & (w_pos[None, :] >= 0)
        p_w = _masked_softmax(jnp.einsum('bqghd,bkgd->bghqk', qx, k_win) * scale, w_mask)
        o_w = jnp.einsum('bghqk,bkgd->bqghd', p_w.astype(v_win.dtype), v_win)
        return gx[..., 0:1] * o_c + gx[..., 1:2] * o_s + gx[..., 2:3] * o_w

    out = lax.map(block, (jnp.arange(nb), q_blocks, g_blocks))
    return jnp.moveaxis(out, 0, 1).reshape(B, S, NSA_HEADS * dh)


def _token_mixer(u, pos, w_in, cmp_pos_k, cmp_pos_v, w_cmp_k, w_cmp_v, w_ret_out, w_nsa_out, w_out):
    B, S, _ = u.shape
    z = jnp.einsum('bsd,de->bse', u, w_in)
    (r_q, r_k, r_v, r_g, n_q, c_k, c_v, s_k, s_v, wn_k, wn_v, n_g, m_ret, m_nsa) = _split_cols(z, IN_SPLITS)
    r_q = _rope(r_q.reshape(B, S, RET_HEADS, RET_DK), pos)
    r_k = _rope(r_k.reshape(B, S, RET_HEADS, RET_DK), pos)
    y_ret = _retention(r_q, r_k, r_v.reshape(B, S, RET_HEADS, RET_DV), r_g)
    y_nsa = _nsa(n_q, c_k, c_v, s_k, s_v, wn_k, wn_v, n_g, pos, cmp_pos_k, cmp_pos_v, w_cmp_k, w_cmp_v)
    merged = (jax.nn.sigmoid(m_ret) * jnp.einsum('bse,ed->bsd', y_ret, w_ret_out)
              + jax.nn.sigmoid(m_nsa) * jnp.einsum('bse,ed->bsd', y_nsa, w_nsa_out))
    return jnp.einsum('bsd,de->bse', merged, w_out)


def _moe(h, w_router, b_router, w_e1, w_e3, w_e2, w_s1, w_s3, w_s2):
    B, S, D = h.shape
    N = B * S
    hf = h.reshape(N, D)
    aff = jax.nn.sigmoid(jnp.dot(hf, w_router).astype(jnp.float32))
    sel_score = aff + b_router.astype(jnp.float32)
    grouped = sel_score.reshape(N, N_EXPERT_GROUPS, N_EXPERTS // N_EXPERT_GROUPS)
    group_score = lax.top_k(grouped, 2)[0].sum(-1)
    _, g_idx = lax.top_k(group_score, TOPK_GROUPS)
    g_keep = jax.nn.one_hot(g_idx, N_EXPERT_GROUPS, dtype=jnp.float32).sum(1) > 0
    e_keep = jnp.repeat(g_keep, N_EXPERTS // N_EXPERT_GROUPS, axis=1)
    _, e_idx = lax.top_k(jnp.where(e_keep, sel_score, NEG_INF), TOP_K)
    w_sel = jnp.take_along_axis(aff, e_idx, axis=1)
    w_sel = w_sel / jnp.sum(w_sel, -1, keepdims=True) * ROUTED_SCALE
    A = N * TOP_K
    flat_e = e_idx.reshape(A)
    order = jnp.argsort(flat_e)
    s_e = flat_e[order]
    s_tok = (order // TOP_K).astype(jnp.int32)
    s_w = w_sel.reshape(A)[order]
    counts = jnp.bincount(flat_e, length=N_EXPERTS)
    starts = jnp.cumsum(counts) - counts
    p_counts = (counts + MOE_BLOCK - 1) // MOE_BLOCK * MOE_BLOCK
    p_ends = jnp.cumsum(p_counts)
    p_starts = p_ends - p_counts
    dest = p_starts[s_e] + jnp.arange(A) - starts[s_e]
    P = A + N_EXPERTS * MOE_BLOCK
    n_blk = P // MOE_BLOCK
    row_tok = jnp.zeros((P,), jnp.int32).at[dest].set(s_tok)
    row_w = jnp.zeros((P,), jnp.float32).at[dest].set(s_w)
    blk_e = jnp.minimum(jnp.searchsorted(p_ends, jnp.arange(n_blk) * MOE_BLOCK, side='right'), N_EXPERTS - 1)

    def expert_block(acc, args):
        e, toks, wts = args
        xb = hf[toks]
        yb = (jax.nn.silu(xb @ w_e1[e]) * (xb @ w_e3[e])) @ w_e2[e]
        return acc.at[toks].add((yb * wts[:, None]).astype(acc.dtype)), None

    routed, _ = lax.scan(expert_block, jnp.zeros((N, D), hf.dtype),
                         (blk_e, row_tok.reshape(n_blk, MOE_BLOCK), row_w.reshape(n_blk, MOE_BLOCK)))
    shared = (jax.nn.silu(hf @ w_s1) * (hf @ w_s3)) @ w_s2
    return (routed + shared).reshape(B, S, D)


def setup_inputs(seed: int = 0) -> dict:
    key = jax.random.key(seed)
    ks = jax.random.split(key, 24)
    beta = (8.0 * DEPTH) ** -0.25
    L = DEPTH

    def nrm(k, shape, scale):
        return jax.random.normal(k, shape, jnp.float32) * scale

    return {
        'x': nrm(ks[0], (BATCH, SEQ, D_MODEL), 1.0),
        'c': nrm(ks[1], (BATCH, D_MODEL), 1.0),
        'w_ada': nrm(ks[2], (L, D_MODEL, 6 * D_MODEL), 0.1 * D_MODEL ** -0.5),
        'b_ada': nrm(ks[3], (L, 6 * D_MODEL), 0.01),
        'w_in': nrm(ks[4], (L, D_MODEL, D_IN), D_MODEL ** -0.5),
        'cmp_pos_k': nrm(ks[5], (L, CMP_LEN, NSA_DH), 0.1),
        'cmp_pos_v': nrm(ks[6], (L, CMP_LEN, NSA_DH), 0.1),
        'w_cmp_k': nrm(ks[7], (L, CMP_LEN, NSA_DH, NSA_DH), (CMP_LEN * NSA_DH) ** -0.5),
        'w_cmp_v': nrm(ks[8], (L, CMP_LEN, NSA_DH, NSA_DH), (CMP_LEN * NSA_DH) ** -0.5),
        'w_ret_out': nrm(ks[9], (L, RET_V_W, D_MODEL), beta * RET_V_W ** -0.5),
        'w_nsa_out': nrm(ks[10], (L, NSA_Q_W, D_MODEL), beta * NSA_Q_W ** -0.5),
        'w_out': nrm(ks[11], (L, D_MODEL, D_MODEL), beta * D_MODEL ** -0.5),
        'ln1_g': 1.0 + nrm(ks[12], (L, D_MODEL), 0.02),
        'ln1_b': nrm(ks[13], (L, D_MODEL), 0.02),
        'w_router': nrm(ks[14], (L, D_MODEL, N_EXPERTS), D_MODEL ** -0.5),
        'b_router': nrm(ks[15], (L, N_EXPERTS), 0.01),
        'w_e1': nrm(ks[16], (L, N_EXPERTS, D_MODEL, D_EXPERT), D_MODEL ** -0.5),
        'w_e3': nrm(ks[17], (L, N_EXPERTS, D_MODEL, D_EXPERT), D_MODEL ** -0.5),
        'w_e2': nrm(ks[18], (L, N_EXPERTS, D_EXPERT, D_MODEL), beta * D_EXPERT ** -0.5),
        'w_s1': nrm(ks[19], (L, D_MODEL, D_SHARED), D_MODEL ** -0.5),
        'w_s3': nrm(ks[20], (L, D_MODEL, D_SHARED), D_MODEL ** -0.5),
        'w_s2': nrm(ks[21], (L, D_SHARED, D_MODEL), beta * D_SHARED ** -0.5),
        'ln2_g': 1.0 + nrm(ks[22], (L, D_MODEL), 0.02),
        'ln2_b': nrm(ks[23], (L, D_MODEL), 0.02),
    }


def reference(x, c, w_ada, b_ada, w_in, cmp_pos_k, cmp_pos_v, w_cmp_k, w_cmp_v,
              w_ret_out, w_nsa_out, w_out, ln1_g, ln1_b, w_router, b_router,
              w_e1, w_e3, w_e2, w_s1, w_s3, w_s2, ln2_g, ln2_b):
    alpha = (2.0 * DEPTH) ** 0.25
    pos = jnp.arange(x.shape[1], dtype=jnp.int32)
    cond = jax.nn.silu(c)
    for l in range(DEPTH):
        mod = jnp.dot(cond, w_ada[l]) + b_ada[l]
        sh1, sc1, g1, sh2, sc2, g2 = jnp.split(mod[:, None, :], 6, axis=-1)
        u = _modulate(x, sh1, sc1)
        mix = _token_mixer(u, pos, w_in[l], cmp_pos_k[l], cmp_pos_v[l], w_cmp_k[l], w_cmp_v[l],
                           w_ret_out[l], w_nsa_out[l], w_out[l])
        x = _layernorm(alpha * x + (1.0 + g1) * mix, ln1_g[l], ln1_b[l])
        h = _modulate(x, sh2, sc2)
        ffn = _moe(h, w_router[l], b_router[l], w_e1[l], w_e3[l], w_e2[l], w_s1[l], w_s3[l], w_s2[l])
        x = _layernorm(alpha * x + (1.0 + g2) * ffn, ln2_g[l], ln2_b[l])
    return x
```

```cpp
#include <hip/hip_runtime.h>
#include <hip/hip_cooperative_groups.h>
#include <cstdio>
#include <cstdint>
namespace cg = cooperative_groups;

#define LAS __attribute__((address_space(3)))
typedef unsigned short bf16_t;
typedef short bf16x8 __attribute__((ext_vector_type(8)));
typedef short s16x4 __attribute__((ext_vector_type(4)));
typedef float f32x4 __attribute__((ext_vector_type(4)));
typedef float f32x2 __attribute__((ext_vector_type(2)));
typedef float f32x16 __attribute__((ext_vector_type(16)));
typedef unsigned u32x4 __attribute__((ext_vector_type(4)));
typedef unsigned u32x2 __attribute__((ext_vector_type(2)));

constexpr int BATCH = 8, SEQ = 4096, DM = 1024, NTOK = BATCH * SEQ;
constexpr int NEXP = 256, TOPK = 8, DEXP = 256;
constexpr int DIN = 6424, DIN_PAD = 6656;
constexpr float LN_EPS = 1e-5f;
constexpr float ALPHA = 1.189207115002721f;
constexpr float ROUTED_SCALE = 2.5f;
constexpr int NWAVES = 8, NTHREADS = 512;

constexpr size_t MiB = 1u << 20, KiB = 1u << 10;
constexpr size_t WS_CTL = 0, CTL_BYTES = 64 * KiB;
constexpr size_t WS_MOD = 64 * KiB;
constexpr size_t WS_CBIAS = 256 * KiB;
constexpr size_t WS_WRT = 1 * MiB;
constexpr size_t WS_WCK = 1 * MiB + 512 * KiB, WS_WCV = 1 * MiB + 768 * KiB;
constexpr size_t WS_WRET = 2 * MiB, WS_WNSA = 4 * MiB, WS_WOUT = 5 * MiB;
constexpr size_t WS_KCMP = 7 * MiB, WS_VCMP = 7 * MiB + 512 * KiB;
constexpr size_t WS_EIDX = 8 * MiB, WS_WSEL = 9 * MiB, WS_LRANK = 10 * MiB, WS_BBASE = 11 * MiB;
constexpr size_t WS_ROWTOK = 12 * MiB, WS_DEST = 14 * MiB, WS_TILEE = 16 * MiB;
constexpr size_t WS_WIN = 17 * MiB;
constexpr size_t WS_E2 = 32 * MiB;
constexpr size_t WS_G = 161 * MiB;
constexpr size_t WS_E13 = 337 * MiB;
constexpr size_t WS_H = 594 * MiB;
constexpr size_t WS_LOGITS = 658 * MiB;
constexpr size_t WS_Y = 337 * MiB;
constexpr int MAX_TILES = 1279 + 128, P_MAX = MAX_TILES * 256;
constexpr size_t WS_U = 32 * MiB;
constexpr size_t WS_RQ = 96 * MiB, WS_RK = 128 * MiB, WS_RV = 160 * MiB, WS_RG = 224 * MiB, WS_NQ = 288 * MiB;
constexpr size_t WS_KV6 = 320 * MiB;
constexpr size_t KVSZ = (size_t)BATCH * 2 * SEQ * 64;
constexpr size_t WS_NG = 368 * MiB;
constexpr size_t WS_MR = 372 * MiB, WS_MN = 436 * MiB;
constexpr size_t WS_KVS = 500 * MiB;
constexpr size_t WS_PREV = 628 * MiB;
constexpr size_t WS_YRET = 692 * MiB, WS_YNSA = 756 * MiB, WS_T1 = 788 * MiB, WS_MG = 852 * MiB;
constexpr size_t WS_END = 916 * MiB;

__device__ __forceinline__ unsigned f2bf(float f) { unsigned u = __builtin_bit_cast(unsigned, f); return (u + 0x7fffu + ((u >> 16) & 1u)) >> 16; }
__device__ __forceinline__ unsigned pk2(float lo, float hi) { return f2bf(lo) | (f2bf(hi) << 16); }
__device__ __forceinline__ float bf_lo(unsigned w) { return __builtin_bit_cast(float, w << 16); }
__device__ __forceinline__ float bf_hi(unsigned w) { return __builtin_bit_cast(float, w & 0xffff0000u); }
__device__ __forceinline__ float wave_sum(float v) {
#pragma unroll
    for (int o = 1; o < 64; o <<= 1) v += __shfl_xor(v, o);
    return v;
}
__device__ __forceinline__ int opaque_tid() { int t = threadIdx.x; asm volatile("" : "+v"(t)); return t; }
__device__ __forceinline__ float sigmoidf_(float x) { return 1.0f / (1.0f + __expf(-x)); }
__device__ __forceinline__ float siluf_(float x) { return x / (1.0f + __expf(-x)); }

namespace pg8 {
constexpr int BM = 256, BK = 64, HALF = 128, HTB = HALF * BK * 2, STAGE_BYTES = 8 * HTB, NXCD = 8, WGM = 8;
__host__ __device__ __forceinline__ int lds_byte(int r, int c) { const int st = (r >> 4) * 2 + (c >> 5), rr = r & 15, cc = c & 31, ob = rr * 64 + cc * 2; return st * 1024 + (ob ^ (((ob >> 9) & 1) << 5)); }
__host__ __device__ __forceinline__ void stage_rc(int b, int& R, int& C) { const int st = b / 1024, sb = b % 1024, swz = sb ^ (((sb >> 9) & 1) << 5); R = (st >> 1) * 16 + swz / 64; C = (st & 1) * 32 + (swz % 64) / 2; }

struct Unit { int pm, pn, pb; };
struct Gemm { const bf16_t* A; const bf16_t* Bt; int K; const int* rows; };

struct StaticOrder {
    int nM, nN, nwg, G, c;
    __device__ void init(int M, int N, int G_, int c_) { nM = M / BM; nN = N / BM; nwg = nM * nN; G = G_; c = c_; }
    __device__ bool next(int i, Unit& u) const {
        const long L = (long)i * G + c; if (L >= nwg) return false;
        int wgid = (int)L; { const int q = nwg / NXCD, r = nwg % NXCD, xcd = wgid % NXCD, off = wgid / NXCD; wgid = (xcd < r ? xcd * (q + 1) : r * (q + 1) + (xcd - r) * q) + off; }
        const int nig = WGM * nN, gid = wgid / nig, fm = gid * WGM, gsz = (nM - fm) < WGM ? (nM - fm) : WGM;
        u.pm = fm + ((wgid % nig) % gsz); u.pn = (wgid % nig) / gsz; u.pb = u.pn; return true;
    }
};
struct MoeOrder {
    const int* tile_e; int ntiles, NC, G, c;
    __device__ bool next(int i, Unit& u) const {
        const long L = (long)i * G + c; if (L >= (long)ntiles * NC) return false;
        u.pm = (int)(L / NC); u.pn = (int)(L % NC); u.pb = tile_e[u.pm] * NC + u.pn; return true;
    }
};

template <class Epi, class Sched, bool GATHER>
__device__ __forceinline__ void gemm_phase(LAS unsigned char* lds, const Gemm g, const Sched& S, const Epi& E) {
    const int tid = opaque_tid(), wid = __builtin_amdgcn_readfirstlane(tid >> 6), lane = tid & 63, wr = wid >> 2, wc = wid & 3, fr = lane & 15, fq = lane >> 4;
    const int K = g.K, nt = K / BK;
    unsigned voffA[2], voffB[2]; int RA[2]; unsigned CA[2];
#pragma unroll
    for (int i = 0; i < 2; ++i) { int R, C; stage_rc(tid * 16 + i * 8192, R, C); voffA[i] = (unsigned)(R * K + C) * 2u; voffB[i] = voffA[i]; RA[i] = R; CA[i] = (unsigned)C * 2u; }
    const size_t kstep = (size_t)(BK * 2);
    const size_t hstep = (size_t)HALF * K * 2;
    const size_t tstep = 2 * hstep;
    const unsigned ldsw = (unsigned)wid * 1024u;
    const int aoff = lds_byte(wr * 64 + fr, fq * 8), boff = lds_byte(wc * 32 + fr, fq * 8);
    unsigned ga[2][2], gn[2][2];
#define PG8_SA(b, h) (((b) * 2 + (h)) * HTB)
#define PG8_SB(b, h) ((4 + (b) * 2 + (h)) * HTB)
#define PG8_STAGE(bufoff, gbase, voff) do { _Pragma("unroll") for (int _i = 0; _i < 2; ++_i) \
        __builtin_amdgcn_global_load_lds((const unsigned*)((const char*)(gbase) + (voff)[_i]), (LAS unsigned*)(lds + (bufoff) + ldsw + _i * 8192), 16, 0, 0); } while (0)
#define PG8_STAGE_A(bufoff, pbase, h, nx) do { if constexpr (GATHER) { \
        const unsigned _o0 = (nx) ? gn[h][0] : ga[h][0], _o1 = (nx) ? gn[h][1] : ga[h][1]; \
        __builtin_amdgcn_global_load_lds((const unsigned*)((const char*)(pbase) + _o0), (LAS unsigned*)(lds + (bufoff) + ldsw), 16, 0, 0); \
        __builtin_amdgcn_global_load_lds((const unsigned*)((const char*)(pbase) + _o1), (LAS unsigned*)(lds + (bufoff) + ldsw + 8192), 16, 0, 0); \
    } else { PG8_STAGE(bufoff, (const char*)(pbase) + ((h) ? hstep : (size_t)0), voffA); } } while (0)
#define PG8_GOFF(dst, pm_) do { if constexpr (GATHER) { _Pragma("unroll") for (int _h = 0; _h < 2; ++_h) _Pragma("unroll") for (int _i = 0; _i < 2; ++_i) \
        dst[_h][_i] = (unsigned)g.rows[(pm_) * BM + _h * HALF + RA[_i]] * (unsigned)(K * 2) + CA[_i]; } } while (0)
#define PG8_LDA(dst, b, h) do { _Pragma("unroll") for (int m = 0; m < 4; ++m) _Pragma("unroll") for (int k = 0; k < 2; ++k) dst[m][k] = *(const LAS bf16x8*)(lds + PG8_SA(b, h) + aoff + m * 2048 + k * 1024); } while (0)
#define PG8_LDB(dst, b, h) do { _Pragma("unroll") for (int n = 0; n < 2; ++n) _Pragma("unroll") for (int k = 0; k < 2; ++k) dst[n][k] = *(const LAS bf16x8*)(lds + PG8_SB(b, h) + boff + n * 2048 + k * 1024); } while (0)
#define PG8_MMA(ai, bj, At, Bt) do { __builtin_amdgcn_s_setprio(1); _Pragma("unroll") for (int m = 0; m < 4; ++m) _Pragma("unroll") for (int n = 0; n < 2; ++n) _Pragma("unroll") for (int k = 0; k < 2; ++k) \
        acc[ai][bj][m][n] = __builtin_amdgcn_mfma_f32_16x16x32_bf16(Bt[n][k], At[m][k], acc[ai][bj][m][n], 0, 0, 0); __builtin_amdgcn_s_setprio(0); } while (0)
#define PG8_WAIT_V(n) asm volatile("s_waitcnt vmcnt(" #n ")" ::: "memory")
#define PG8_WAIT_L(n) asm volatile("s_waitcnt lgkmcnt(" #n ")" ::: "memory")
#define PG8_BAR __builtin_amdgcn_s_barrier()
#define PG8_SCHED __builtin_amdgcn_sched_barrier(0)
    Unit cur, nxt; int ui = 0;
    if (!S.next(0, cur)) return;
    f32x4 acc[2][2][4][2];
#pragma unroll
    for (int a = 0; a < 2; ++a)
#pragma unroll
        for (int b = 0; b < 2; ++b)
#pragma unroll
            for (int m = 0; m < 4; ++m)
#pragma unroll
                for (int n = 0; n < 2; ++n) acc[a][b][m][n] = (f32x4){0.f, 0.f, 0.f, 0.f};
    bf16x8 At[4][2], B0[2][2], B1[2][2];
    const char* cA = GATHER ? (const char*)g.A : (const char*)g.A + (size_t)cur.pm * tstep; const char* cB = (const char*)g.Bt + (size_t)cur.pb * tstep;
    PG8_GOFF(ga, cur.pm);
    PG8_STAGE(PG8_SB(0, 0), cB, voffB); PG8_STAGE(PG8_SB(0, 1), cB + hstep, voffB); PG8_STAGE_A(PG8_SA(0, 0), cA, 0, false); PG8_STAGE_A(PG8_SA(0, 1), cA, 1, false);
    if (wr == 1) PG8_BAR;
    PG8_WAIT_V(2); PG8_BAR;
    PG8_STAGE(PG8_SB(1, 0), cB + kstep, voffB); PG8_STAGE_A(PG8_SA(1, 0), cA + kstep, 0, false); PG8_STAGE(PG8_SB(1, 1), cB + hstep + kstep, voffB);
    PG8_WAIT_V(6); PG8_BAR;
    for (;;) {
        const bool has_next = S.next(ui + 1, nxt);
        const char* nA = has_next ? (GATHER ? (const char*)g.A : (const char*)g.A + (size_t)nxt.pm * tstep) : cA; const char* nB = has_next ? (const char*)g.Bt + (size_t)nxt.pb * tstep : cB;
        if constexpr (GATHER) { if (has_next) { PG8_GOFF(gn, nxt.pm); } else {
#pragma unroll
            for (int _h = 0; _h < 2; ++_h)
#pragma unroll
                for (int _i = 0; _i < 2; ++_i) gn[_h][_i] = ga[_h][_i]; } }
        for (int t = 0; t < nt; t += 2) {
            const bool last = (t == nt - 2);
            const char* a1 = cA + (size_t)(t + 1) * kstep;
            const char* a2 = last ? nA : cA + (size_t)(t + 2) * kstep; const char* b2 = last ? nB : cB + (size_t)(t + 2) * kstep;
            const char* a3 = a2 + kstep; const char* b3 = b2 + kstep;
            PG8_LDB(B0, 0, 0); PG8_LDB(B1, 0, 1); PG8_SCHED; PG8_LDA(At, 0, 0); PG8_STAGE_A(PG8_SA(1, 1), a1, 1, false);
            PG8_WAIT_V(8); PG8_WAIT_L(0); PG8_BAR; PG8_MMA(0, 0, At, B0); PG8_MMA(0, 1, At, B1); PG8_BAR; PG8_SCHED;
            PG8_LDA(At, 0, 1); PG8_STAGE(PG8_SB(0, 0), b2, voffB); PG8_STAGE(PG8_SB(0, 1), b2 + hstep, voffB); PG8_STAGE_A(PG8_SA(0, 0), a2, 0, last);
            PG8_WAIT_V(8); PG8_WAIT_L(0); PG8_BAR; PG8_MMA(1, 0, At, B0); PG8_MMA(1, 1, At, B1); PG8_BAR; PG8_SCHED;
            PG8_LDB(B0, 1, 0); PG8_LDB(B1, 1, 1); PG8_SCHED; PG8_LDA(At, 1, 0); PG8_STAGE_A(PG8_SA(0, 1), a2, 1, last);
            PG8_WAIT_V(8); PG8_WAIT_L(0); PG8_BAR; PG8_MMA(0, 0, At, B0); PG8_MMA(0, 1, At, B1); PG8_BAR; PG8_SCHED;
            PG8_LDA(At, 1, 1); PG8_STAGE(PG8_SB(1, 0), b3, voffB); PG8_STAGE(PG8_SB(1, 1), b3 + hstep, voffB); PG8_STAGE_A(PG8_SA(1, 0), a3, 0, last);
            PG8_WAIT_V(8); PG8_WAIT_L(0); PG8_BAR; PG8_MMA(1, 0, At, B0); PG8_MMA(1, 1, At, B1); PG8_BAR; PG8_SCHED;
        }
        if (wr == 0) PG8_BAR;
        E(acc, cur, wr, wc, fr, fq);
        if (!has_next) break;
#pragma unroll
        for (int a = 0; a < 2; ++a)
#pragma unroll
            for (int b = 0; b < 2; ++b)
#pragma unroll
                for (int m = 0; m < 4; ++m)
#pragma unroll
                    for (int n = 0; n < 2; ++n) acc[a][b][m][n] = (f32x4){0.f, 0.f, 0.f, 0.f};
        cur = nxt; cA = nA; cB = nB; ++ui;
        if constexpr (GATHER) {
#pragma unroll
            for (int _h = 0; _h < 2; ++_h)
#pragma unroll
                for (int _i = 0; _i < 2; ++_i) ga[_h][_i] = gn[_h][_i]; }
        if (wr == 1) PG8_BAR;
    }
    PG8_WAIT_V(0);
    PG8_BAR;
#undef PG8_SA
#undef PG8_SB
#undef PG8_STAGE
#undef PG8_STAGE_A
#undef PG8_GOFF
#undef PG8_LDA
#undef PG8_LDB
#undef PG8_MMA
#undef PG8_WAIT_V
#undef PG8_WAIT_L
#undef PG8_BAR
#undef PG8_SCHED
}

struct EpiF32 {
    float* C; int ldc;
    __device__ __forceinline__ void operator()(const f32x4 (&acc)[2][2][4][2], const Unit& u, int wr, int wc, int fr, int fq) const {
        const int row0 = u.pm * BM + wr * 64 + fr, col0 = u.pn * BM + wc * 32 + 4 * fq;
#pragma unroll
        for (int ai = 0; ai < 2; ++ai)
#pragma unroll
            for (int m = 0; m < 4; ++m) { float* rowp = C + (size_t)(row0 + ai * HALF + m * 16) * ldc + col0;
#pragma unroll
                for (int bj = 0; bj < 2; ++bj)
#pragma unroll
                    for (int n = 0; n < 2; ++n) *(f32x4*)(rowp + bj * HALF + n * 16) = acc[ai][bj][m][n]; }
    }
};
struct EpiSwiGlu {
    bf16_t* G;
    __device__ __forceinline__ void operator()(const f32x4 (&acc)[2][2][4][2], const Unit& u, int wr, int wc, int fr, int fq) const {
        const int row0 = u.pm * BM + wr * 64 + fr, c0 = u.pn * 128 + wc * 16 + 4 * fq;
#pragma unroll
        for (int ai = 0; ai < 2; ++ai)
#pragma unroll
            for (int m = 0; m < 4; ++m) { bf16_t* rowp = G + (size_t)(row0 + ai * HALF + m * 16) * DEXP + c0;
#pragma unroll
                for (int bj = 0; bj < 2; ++bj) { const f32x4 a1 = acc[ai][bj][m][0], a3 = acc[ai][bj][m][1];
                    u32x2 w; w.x = pk2(siluf_(a1[0]) * a3[0], siluf_(a1[1]) * a3[1]); w.y = pk2(siluf_(a1[2]) * a3[2], siluf_(a1[3]) * a3[3]);
                    *(u32x2*)(rowp + bj * 64) = w; } }
    }
};
struct EpiScatter {
    bf16_t* Y; const int* dest;
    __device__ __forceinline__ void operator()(const f32x4 (&acc)[2][2][4][2], const Unit& u, int wr, int wc, int fr, int fq) const {
        const int row0 = u.pm * BM + wr * 64 + fr, col0 = u.pn * BM + wc * 32 + 4 * fq;
#pragma unroll
        for (int ai = 0; ai < 2; ++ai)
#pragma unroll
            for (int m = 0; m < 4; ++m) { const int d = dest[row0 + ai * HALF + m * 16];
                if (d >= 0) { bf16_t* rowp = Y + (size_t)d * DM + col0;
#pragma unroll
                    for (int bj = 0; bj < 2; ++bj)
#pragma unroll
                        for (int n = 0; n < 2; ++n) { const f32x4 v = acc[ai][bj][m][n]; u32x2 w; w.x = pk2(v[0], v[1]); w.y = pk2(v[2], v[3]); *(u32x2*)(rowp + bj * HALF + n * 16) = w; } } }
    }
};

__device__ __forceinline__ void sincos_rev(float rev, float& s, float& c) { rev = rev - floorf(rev); s = __builtin_amdgcn_sinf(rev); c = __builtin_amdgcn_cosf(rev); }
struct EpiInProj {
    unsigned char* wsb;
    template <int BJ> __device__ __forceinline__ void half(const f32x4 (&acc)[2][2][4][2], const Unit& u, int wr, int wc, int fr, int fq) const {
        const int ht = 2 * u.pn + BJ; const int row0 = u.pm * BM + wr * 64 + fr;
        if (ht < 8) {
            const int i0 = 16 * wc + 4 * fq; float invf[4];
#pragma unroll
            for (int e = 0; e < 4; ++e) invf[e] = __builtin_amdgcn_exp2f(-(float)(i0 + e) * (13.287712379549449f / 64.0f)) * 0.15915494309189535f;
            bf16_t* dst = (bf16_t*)(wsb + ((ht < 4) ? WS_RQ : WS_RK)); const float sc = (ht < 4) ? 1.0f : 0.08838834764831845f; const int hh = ht & 3;
#pragma unroll
            for (int ai = 0; ai < 2; ++ai)
#pragma unroll
                for (int m = 0; m < 4; ++m) { const int row = row0 + ai * HALF + m * 16; const float t = (float)(row & (SEQ - 1));
                    const f32x4 v0 = acc[ai][BJ][m][0], v1 = acc[ai][BJ][m][1]; float o1[4], o2[4];
#pragma unroll
                    for (int e = 0; e < 4; ++e) { float sn, cs; sincos_rev(t * invf[e], sn, cs); o1[e] = (v0[e] * cs - v1[e] * sn) * sc; o2[e] = (v1[e] * cs + v0[e] * sn) * sc; }
                    bf16_t* p = dst + (size_t)row * 512 + hh * 128 + i0;
                    u32x2 w; w.x = pk2(o1[0], o1[1]); w.y = pk2(o1[2], o1[3]); *(u32x2*)p = w; w.x = pk2(o2[0], o2[1]); w.y = pk2(o2[2], o2[3]); *(u32x2*)(p + 64) = w; asm volatile("" ::: "memory"); }
        } else if (ht < 24 || (ht >= 35 && ht < 51)) {
            size_t doff; int hb, act;
            if (ht < 16) { doff = WS_RV; hb = ht - 8; act = 0; } else if (ht < 24) { doff = WS_RG; hb = ht - 16; act = 1; } else if (ht < 43) { doff = WS_MR; hb = ht - 35; act = 2; } else { doff = WS_MN; hb = ht - 43; act = 2; }
            bf16_t* dst = (bf16_t*)(wsb + doff);
            const int col0 = hb * 128 + 32 * wc + 4 * fq;
#pragma unroll
            for (int ai = 0; ai < 2; ++ai)
#pragma unroll
                for (int m = 0; m < 4; ++m) { const int row = row0 + ai * HALF + m * 16;
#pragma unroll
                    for (int n = 0; n < 2; ++n) { f32x4 v = acc[ai][BJ][m][n];
                        if (act == 1) { v[0] = siluf_(v[0]); v[1] = siluf_(v[1]); v[2] = siluf_(v[2]); v[3] = siluf_(v[3]); }
                        else if (act == 2) { v[0] = sigmoidf_(v[0]); v[1] = sigmoidf_(v[1]); v[2] = sigmoidf_(v[2]); v[3] = sigmoidf_(v[3]); }
                        u32x2 w; w.x = pk2(v[0], v[1]); w.y = pk2(v[2], v[3]); *(u32x2*)(dst + (size_t)row * 1024 + col0 + 16 * n) = w; } asm volatile("" ::: "memory"); }
        } else if (ht < 28 || ht == 28 || ht == 30 || ht == 32) {
            const int hin = wc >> 1, j0 = 16 * (wc & 1) + 4 * fq; float invf[4];
#pragma unroll
            for (int e = 0; e < 4; ++e) invf[e] = __builtin_amdgcn_exp2f(-(float)(j0 + e) * (13.287712379549449f / 32.0f)) * 0.15915494309189535f;
#pragma unroll
            for (int ai = 0; ai < 2; ++ai)
#pragma unroll
                for (int m = 0; m < 4; ++m) { const int row = row0 + ai * HALF + m * 16; const int tt = row & (SEQ - 1), b = row >> 12; const float t = (float)tt;
                    const f32x4 v0 = acc[ai][BJ][m][0], v1 = acc[ai][BJ][m][1]; float o1[4], o2[4];
#pragma unroll
                    for (int e = 0; e < 4; ++e) { float sn, cs; sincos_rev(t * invf[e], sn, cs); o1[e] = v0[e] * cs - v1[e] * sn; o2[e] = v1[e] * cs + v0[e] * sn; }
                    const size_t eo = (ht < 28) ? WS_NQ / 2 + (size_t)row * 512 + ((ht - 24) * 2 + hin) * 64 + j0
                                                : WS_KV6 / 2 + (size_t)(ht - 28) * KVSZ + ((size_t)(b * 2 + hin) * SEQ + tt) * 64 + j0;
                    bf16_t* p = (bf16_t*)wsb + eo;
                    u32x2 w; w.x = pk2(o1[0], o1[1]); w.y = pk2(o1[2], o1[3]); *(u32x2*)p = w; w.x = pk2(o2[0], o2[1]); w.y = pk2(o2[2], o2[3]); *(u32x2*)(p + 32) = w; asm volatile("" ::: "memory"); }
        } else if (ht == 29 || ht == 31 || ht == 33) {
            const int hin = wc >> 1, d0 = 32 * (wc & 1) + 4 * fq;
#pragma unroll
            for (int ai = 0; ai < 2; ++ai)
#pragma unroll
                for (int m = 0; m < 4; ++m) { const int row = row0 + ai * HALF + m * 16; const int tt = row & (SEQ - 1), b = row >> 12;
                    bf16_t* p = (bf16_t*)(wsb + WS_KV6) + (size_t)(ht - 28) * KVSZ + ((size_t)(b * 2 + hin) * SEQ + tt) * 64 + d0;
#pragma unroll
                    for (int n = 0; n < 2; ++n) { const f32x4 v = acc[ai][BJ][m][n]; u32x2 w; w.x = pk2(v[0], v[1]); w.y = pk2(v[2], v[3]); *(u32x2*)(p + 16 * n) = w; } }
        } else if (ht == 34) {
            if (wc == 0) {
#pragma unroll
                for (int ai = 0; ai < 2; ++ai)
#pragma unroll
                    for (int m = 0; m < 4; ++m) { const int row = row0 + ai * HALF + m * 16;
#pragma unroll
                        for (int n = 0; n < 2; ++n) { if (n == 0 || fq < 2) { const f32x4 v = acc[ai][BJ][m][n];
                            *(f32x4*)((float*)(wsb + WS_NG) + (size_t)row * 32 + 16 * n + 4 * fq) = (f32x4){sigmoidf_(v[0]), sigmoidf_(v[1]), sigmoidf_(v[2]), sigmoidf_(v[3])}; } } }
            }
        }
    }
    __device__ __forceinline__ void operator()(const f32x4 (&acc)[2][2][4][2], const Unit& u, int wr, int wc, int fr, int fq) const {
        half<0>(acc, u, wr, wc, fr, fq); half<1>(acc, u, wr, wc, fr, fq);
    }
};
struct EpiGate {
    bf16_t* O; const bf16_t* gate; const bf16_t* add;
    __device__ __forceinline__ void operator()(const f32x4 (&acc)[2][2][4][2], const Unit& u, int wr, int wc, int fr, int fq) const {
        const int row0 = u.pm * BM + wr * 64 + fr, col0 = u.pn * BM + wc * 32 + 4 * fq;
#pragma unroll
        for (int ai = 0; ai < 2; ++ai)
#pragma unroll
            for (int m = 0; m < 4; ++m) { const size_t off = (size_t)(row0 + ai * HALF + m * 16) * 1024 + col0;
#pragma unroll
                for (int bj = 0; bj < 2; ++bj)
#pragma unroll
                    for (int n = 0; n < 2; ++n) { const size_t o = off + bj * HALF + n * 16; const f32x4 v = acc[ai][bj][m][n]; const u32x2 gt = *(const u32x2*)(gate + o);
                        float r0 = v[0] * bf_lo(gt.x), r1 = v[1] * bf_hi(gt.x), r2 = v[2] * bf_lo(gt.y), r3 = v[3] * bf_hi(gt.y);
                        if (add) { const u32x2 ad = *(const u32x2*)(add + o); r0 += bf_lo(ad.x); r1 += bf_hi(ad.x); r2 += bf_lo(ad.y); r3 += bf_hi(ad.y); }
                        u32x2 w; w.x = pk2(r0, r1); w.y = pk2(r2, r3); *(u32x2*)(O + o) = w; } }
    }
};
struct EpiResid {
    float* O; const float* xin; const float* mod;
    __device__ __forceinline__ void operator()(const f32x4 (&acc)[2][2][4][2], const Unit& u, int wr, int wc, int fr, int fq) const {
        const int row0 = u.pm * BM + wr * 64 + fr, col0 = u.pn * BM + wc * 32 + 4 * fq; const int b = (u.pm * BM) >> 12;
        f32x4 g1[2][2];
#pragma unroll
        for (int bj = 0; bj < 2; ++bj)
#pragma unroll
            for (int n = 0; n < 2; ++n) g1[bj][n] = *(const f32x4*)(mod + b * 6144 + 2048 + col0 + bj * HALF + n * 16) + 1.0f;
#pragma unroll
        for (int ai = 0; ai < 2; ++ai)
#pragma unroll
            for (int m = 0; m < 4; ++m) { const size_t off = (size_t)(row0 + ai * HALF + m * 16) * 1024 + col0;
#pragma unroll
                for (int bj = 0; bj < 2; ++bj)
#pragma unroll
                    for (int n = 0; n < 2; ++n) { const size_t o = off + bj * HALF + n * 16; *(f32x4*)(O + o) = *(const f32x4*)(xin + o) * ALPHA + g1[bj][n] * acc[ai][bj][m][n]; } }
    }
};
}


typedef short v4i16_t __attribute__((ext_vector_type(4)));
__device__ __forceinline__ int crow(int r, int hi) { return (r & 3) + 8 * (r >> 2) + 4 * hi; }
__device__ __forceinline__ unsigned cvtpk(float lo, float hi) { unsigned r; asm volatile("v_cvt_pk_bf16_f32 %0, %1, %2" : "=v"(r) : "v"(lo), "v"(hi)); return r; }
#define KSWZ256(row, colB) ((row) * 256 + ((colB) ^ (((row) & 7) << 4)))
#define KSWZ128(row, colB) ((row) * 128 + ((colB) ^ (((row) & 7) << 4)))
template <int NCB> __device__ __forceinline__ int tr_st(int i, int c) { const int ii = (i & ~0xC) | ((i & 4) << 1) | ((i & 8) >> 1); return ((ii >> 3) * NCB + (c >> 5)) * 512 + ((ii & 7) * 32 + (c & 31)) * 2; }
__device__ __forceinline__ int tr_rd_base(int lane) { return ((lane & 3) << 3) | (((lane >> 2) & 3) << 6) | (((lane >> 4) & 1) << 5) | (((lane >> 5) & 1) << 8); }
template <int NCB> __device__ __forceinline__ bf16x8 tr_frag(LAS const unsigned char* imgb, int cb, int s16) {
    const v4i16_t lo = __builtin_amdgcn_ds_read_tr16_b64_v4i16((LAS v4i16_t*)(imgb + ((2 * s16) * NCB + cb) * 512));
    const v4i16_t hi = __builtin_amdgcn_ds_read_tr16_b64_v4i16((LAS v4i16_t*)(imgb + ((2 * s16 + 1) * NCB + cb) * 512));
    return (bf16x8){lo[0], lo[1], lo[2], lo[3], hi[0], hi[1], hi[2], hi[3]};
}
#define PK4(P, BASE, OUT) do { unsigned a0_ = cvtpk(P[BASE + 0], P[BASE + 1]), a1_ = cvtpk(P[BASE + 2], P[BASE + 3]);   \
    unsigned b0_ = cvtpk(P[BASE + 4], P[BASE + 5]), b1_ = cvtpk(P[BASE + 6], P[BASE + 7]);                              \
    auto r0_ = __builtin_amdgcn_permlane32_swap(a0_, b0_, false, false); auto r1_ = __builtin_amdgcn_permlane32_swap(a1_, b1_, false, false); \
    u32x4 w_ = {r0_[0], r1_[0], r0_[1], r1_[1]}; OUT = __builtin_bit_cast(bf16x8, w_); } while (0)

__device__ __forceinline__ float ret_log2gamma(int h) { return h == 0 ? -0.045803689613f : h == 1 ? -0.022720076500f : h == 2 ? -0.011315313227f : -0.005646563141f; }
__device__ __forceinline__ bf16x8 scale_bf8(bf16x8 v, float f) {
    u32x4 w = __builtin_bit_cast(u32x4, v);
    w.x = pk2(bf_lo(w.x) * f, bf_hi(w.x) * f); w.y = pk2(bf_lo(w.y) * f, bf_hi(w.y) * f); w.z = pk2(bf_lo(w.z) * f, bf_hi(w.z) * f); w.w = pk2(bf_lo(w.w) * f, bf_hi(w.w) * f);
    return __builtin_bit_cast(bf16x8, w);
}
__device__ __forceinline__ void ret_kv_unit(int unit, const bf16_t* RK, const bf16_t* RV, float* KVS, LAS unsigned char* lds) {
    const int tid = opaque_tid(), lane = tid & 63, wave = __builtin_amdgcn_readfirstlane(tid >> 6), r32 = lane & 31, hi = lane >> 5;
    const int b = unit >> 7, n = (unit >> 2) & 31, h = unit & 3; const size_t tok0 = (size_t)b * SEQ + n * 128; const float lg = ret_log2gamma(h);
    LAS unsigned char* Vimg = lds; LAS unsigned char* Kimg = lds + 65536;
#pragma unroll
    for (int j = 0; j < 8; ++j) { const int p = tid + 512 * j, i = p >> 5, c = (p & 31) * 8;
        *(LAS bf16x8*)(Vimg + tr_st<8>(i, c)) = *(const bf16x8*)(RV + (tok0 + i) * 1024 + h * 256 + c); }
#pragma unroll
    for (int j = 0; j < 4; ++j) { const int p = tid + 512 * j, i = p >> 4, c = (p & 15) * 8;
        const bf16x8 kv = *(const bf16x8*)(RK + (tok0 + i) * 512 + h * 128 + c);
        *(LAS bf16x8*)(Kimg + tr_st<4>(i, c)) = scale_bf8(kv, __builtin_amdgcn_exp2f((float)(127 - i) * lg)); }
    __syncthreads();
    f32x16 acc[4];
#pragma unroll
    for (int db = 0; db < 4; ++db) acc[db] = f32x16{};
    const int rb = tr_rd_base(lane);
#pragma unroll
    for (int s16 = 0; s16 < 8; ++s16) {
        const bf16x8 af = tr_frag<8>(Vimg + rb, wave, s16);
#pragma unroll
        for (int db = 0; db < 4; ++db) { const bf16x8 bf = tr_frag<4>(Kimg + rb, db, s16); acc[db] = __builtin_amdgcn_mfma_f32_32x32x16_bf16(af, bf, acc[db], 0, 0, 0); }
    }
    float* dst = KVS + (size_t)unit * 32768;
#pragma unroll
    for (int r = 0; r < 16; ++r) { const int e = 32 * wave + crow(r, hi);
#pragma unroll
        for (int db = 0; db < 4; ++db) dst[e * 128 + 32 * db + r32] = acc[db][r]; }
    __syncthreads();
}
__device__ __forceinline__ void ret_out_unit(int unit, const bf16_t* RQ, const bf16_t* RK, const bf16_t* RV, const bf16_t* RGs, const bf16_t* PREV, bf16_t* YRET, LAS unsigned char* lds) {
    const int tid = opaque_tid(), lane = tid & 63, wave = __builtin_amdgcn_readfirstlane(tid >> 6), r32 = lane & 31, hi = lane >> 5, wr = wave >> 1, wc = wave & 1;
    const int b = unit >> 7, n = (unit >> 2) & 31, h = unit & 3; const size_t tok0 = (size_t)b * SEQ + n * 128; const float lg = ret_log2gamma(h);
    LAS unsigned char* Pimg = lds; LAS unsigned char* Vimg = lds; LAS unsigned char* Kimg = lds + 65536; LAS float* stats = (LAS float*)(lds + 98304);
    const bf16_t* prev = PREV + (size_t)unit * 32768;
#pragma unroll
    for (int j = 0; j < 8; ++j) { const int p = tid + 512 * j, e = p >> 4, cB = (p & 15) * 16; *(LAS bf16x8*)(Pimg + KSWZ256(e, cB)) = *(const bf16x8*)(prev + e * 128 + (cB >> 1)); }
#pragma unroll
    for (int j = 0; j < 4; ++j) { const int p = tid + 512 * j, jj = p >> 4, cB = (p & 15) * 16; *(LAS bf16x8*)(Kimg + KSWZ256(jj, cB)) = *(const bf16x8*)(RK + (tok0 + jj) * 512 + h * 128 + (cB >> 1)); }
    bf16x8 vreg[8];
#pragma unroll
    for (int j = 0; j < 8; ++j) { const int p = tid + 512 * j, i = p >> 5, c = (p & 31) * 8; vreg[j] = *(const bf16x8*)(RV + (tok0 + i) * 1024 + h * 256 + c); }
    bf16x8 qr[8];
#pragma unroll
    for (int d0 = 0; d0 < 8; ++d0) qr[d0] = *(const bf16x8*)(RQ + (tok0 + 32 * wr + r32) * 512 + h * 128 + 16 * d0 + 8 * hi);
    __syncthreads();
    f32x16 o[4];
#pragma unroll
    for (int cb = 0; cb < 4; ++cb) { o[cb] = f32x16{};
#pragma unroll
        for (int d0 = 0; d0 < 8; ++d0) { const bf16x8 bf = *(const LAS bf16x8*)(Pimg + KSWZ256(128 * wc + 32 * cb + r32, (16 * d0 + 8 * hi) * 2));
            o[cb] = __builtin_amdgcn_mfma_f32_32x32x16_bf16(qr[d0], bf, o[cb], 0, 0, 0); } }
#pragma unroll
    for (int r = 0; r < 16; ++r) { const float xi = __builtin_amdgcn_exp2f((float)(32 * wr + crow(r, hi) + 1) * lg);
#pragma unroll
        for (int cb = 0; cb < 4; ++cb) o[cb][r] *= xi; }
    __syncthreads();
#pragma unroll
    for (int j = 0; j < 8; ++j) { const int p = tid + 512 * j, i = p >> 5, c = (p & 31) * 8; *(LAS bf16x8*)(Vimg + tr_st<8>(i, c)) = vreg[j]; }
    __syncthreads();
    const int rb = tr_rd_base(lane);
#pragma unroll 1
    for (int jb = 0; jb <= wr; ++jb) {
        f32x16 p = f32x16{};
#pragma unroll
        for (int d0 = 0; d0 < 8; ++d0) { const bf16x8 af = *(const LAS bf16x8*)(Kimg + KSWZ256(32 * jb + r32, (16 * d0 + 8 * hi) * 2));
            p = __builtin_amdgcn_mfma_f32_32x32x16_bf16(af, qr[d0], p, 0, 0, 0); }
        const int iq = 32 * wr + r32;
#pragma unroll
        for (int r = 0; r < 16; ++r) { const int diff = iq - (32 * jb + crow(r, hi)); p[r] = diff >= 0 ? p[r] * __builtin_amdgcn_exp2f((float)diff * lg) : 0.f; }
        bf16x8 pa0, pa1; PK4(p, 0, pa0); PK4(p, 8, pa1);
#pragma unroll
        for (int cb = 0; cb < 4; ++cb) {
            const bf16x8 v0 = tr_frag<8>(Vimg + rb, 4 * wc + cb, 2 * jb), v1 = tr_frag<8>(Vimg + rb, 4 * wc + cb, 2 * jb + 1);
            o[cb] = __builtin_amdgcn_mfma_f32_32x32x16_bf16(pa0, v0, o[cb], 0, 0, 0);
            o[cb] = __builtin_amdgcn_mfma_f32_32x32x16_bf16(pa1, v1, o[cb], 0, 0, 0); }
    }
#pragma unroll
    for (int r = 0; r < 16; ++r) { float sm = (o[0][r] + o[1][r]) + (o[2][r] + o[3][r]); float sq = (o[0][r] * o[0][r] + o[1][r] * o[1][r]) + (o[2][r] * o[2][r] + o[3][r] * o[3][r]);
#pragma unroll
        for (int x = 1; x < 32; x <<= 1) { sm += __shfl_xor(sm, x); sq += __shfl_xor(sq, x); }
        if (r32 == 0) { stats[((wr * 2 + wc) * 32 + crow(r, hi)) * 2] = sm; stats[((wr * 2 + wc) * 32 + crow(r, hi)) * 2 + 1] = sq; } }
    __syncthreads();
#pragma unroll
    for (int r = 0; r < 16; ++r) { const int row = crow(r, hi);
        const float sm = stats[((wr * 2) * 32 + row) * 2] + stats[((wr * 2 + 1) * 32 + row) * 2], sq = stats[((wr * 2) * 32 + row) * 2 + 1] + stats[((wr * 2 + 1) * 32 + row) * 2 + 1];
        const float mean = sm * (1.f / 256.f), var = fmaxf(sq * (1.f / 256.f) - mean * mean, 0.f), rstd = 1.f / sqrtf(var + LN_EPS);
        const size_t off = (tok0 + 32 * wr + row) * 1024 + h * 256 + 128 * wc + r32;
#pragma unroll
        for (int cb = 0; cb < 4; ++cb) { const float gsl = __builtin_bit_cast(float, (unsigned)RGs[off + 32 * cb] << 16);
            YRET[off + 32 * cb] = (bf16_t)f2bf((o[cb][r] - mean) * rstd * gsl); }
        if (r & 1) asm volatile("" ::: "memory"); }
    __syncthreads();
}

__device__ __forceinline__ void nsa_cmp_unit(int unit, const bf16_t* KV6p, const bf16_t* WCKp, const float* CBIASp, bf16_t* KCMPp, LAS unsigned char* lds) {
    const int tid = opaque_tid(), lane = tid & 63, wave = __builtin_amdgcn_readfirstlane(tid >> 6), r32 = lane & 31, hi = lane >> 5;
    const int which = unit >> 7, rb = unit & 127;
    const bf16_t* arr = KV6p + (size_t)which * KVSZ; const bf16_t* Wt = WCKp + (size_t)which * (64 * 2048);
    f32x16 acc[2]; acc[0] = f32x16{}; acc[1] = f32x16{};
    const bf16_t* ap = arr + (size_t)(rb * 32 + r32) * 1024 + wave * 256 + 8 * hi;
    const bf16_t* bp = Wt + (size_t)r32 * 2048 + wave * 256 + 8 * hi;
#pragma unroll 4
    for (int ks = 0; ks < 16; ++ks) {
        const bf16x8 af = *(const bf16x8*)(ap + 16 * ks), b0 = *(const bf16x8*)(bp + 16 * ks), b1 = *(const bf16x8*)(bp + 32 * 2048 + 16 * ks);
        acc[0] = __builtin_amdgcn_mfma_f32_32x32x16_bf16(af, b0, acc[0], 0, 0, 0);
        acc[1] = __builtin_amdgcn_mfma_f32_32x32x16_bf16(af, b1, acc[1], 0, 0, 0);
    }
    LAS float* red = (LAS float*)lds;
#pragma unroll
    for (int r = 0; r < 16; ++r) { red[(wave * 32 + crow(r, hi)) * 64 + r32] = acc[0][r]; red[(wave * 32 + crow(r, hi)) * 64 + 32 + r32] = acc[1][r]; }
    __syncthreads();
#pragma unroll
    for (int q = 0; q < 4; ++q) { const int idx = tid + 512 * q, row = idx >> 6, e = idx & 63; float sacc = CBIASp[which * 64 + e];
#pragma unroll
        for (int w = 0; w < 8; ++w) sacc += red[(w * 32 + row) * 64 + e];
        KCMPp[(size_t)which * (4096 * 64) + (size_t)(rb * 32 + row) * 64 + e] = (bf16_t)f2bf(sacc); }
    __syncthreads();
}

constexpr float NSA_C = 0.125f * 1.4426950408889634f;
template <int GRP>
__device__ __forceinline__ void nsa_tile(const int MODE, f32x16 (&o)[2], float& m_reg, float& l_reg, LAS const unsigned char* Kt, LAS const unsigned char* Vtrb, const bf16x8 (&qr)[4],
                                         LAS float* al_l, int r32, int hi, int qb, int tl, int j, bool selrow) {
    asm volatile("" : "+v"(r32), "+v"(hi));
    f32x16 p0 = f32x16{}, p1 = f32x16{};
#pragma unroll
    for (int d0 = 0; d0 < 4; ++d0) { const int cb = (d0 * 16 + hi * 8) * 2;
        const bf16x8 b0 = *(const LAS bf16x8*)(Kt + KSWZ128(r32, cb)), b1 = *(const LAS bf16x8*)(Kt + KSWZ128(32 + r32, cb));
        p0 = __builtin_amdgcn_mfma_f32_32x32x16_bf16(b0, qr[d0], p0, 0, 0, 0); p1 = __builtin_amdgcn_mfma_f32_32x32x16_bf16(b1, qr[d0], p1, 0, 0, 0); }
    __builtin_amdgcn_sched_barrier(0);
    const float NEG = -INFINITY;
#define KC(r) (((r) & 3) + 8 * ((r) >> 2))
    if (GRP == 0) { int lim = 64 * qb + tl - 31 - 1024 * j - 64 * hi;
        asm volatile("" : "+v"(lim));
#pragma unroll
        for (int r = 0; r < 16; ++r) { if (16 * KC(r) > lim) p0[r] = NEG; if (16 * KC(r) + 512 > lim) p1[r] = NEG; }
    } else if (MODE == 1) {
        int t2 = selrow ? ((j == qb) ? tl - 4 * hi : 1000) : -1000;
        asm volatile("" : "+v"(t2));
#pragma unroll
        for (int r = 0; r < 16; ++r) { if (KC(r) > t2) p0[r] = NEG; if (KC(r) + 32 > t2) p1[r] = NEG; }
    } else {
        if (j == qb) { int t2 = tl - 4 * hi; asm volatile("" : "+v"(t2));
#pragma unroll
            for (int r = 0; r < 16; ++r) { if (KC(r) > t2) p0[r] = NEG; if (KC(r) + 32 > t2) p1[r] = NEG; }
        } else if (j == qb - 8) { int t2 = tl - 4 * hi; asm volatile("" : "+v"(t2));
#pragma unroll
            for (int r = 0; r < 16; ++r) { if (KC(r) <= t2) p0[r] = NEG; if (KC(r) + 32 <= t2) p1[r] = NEG; }
        }
    }
#undef KC
    bf16x8 pa[4];
    if (GRP == 0 && MODE == 3) {
        const float mnC = -m_reg * NSA_C;
#pragma unroll
        for (int r = 0; r < 16; ++r) { p0[r] = __builtin_amdgcn_exp2f(fmaf(p0[r], NSA_C, mnC)); p1[r] = __builtin_amdgcn_exp2f(fmaf(p1[r], NSA_C, mnC)); }
    } else {
        float pmax = p0[0];
#pragma unroll
        for (int r = 1; r < 16; ++r) pmax = fmaxf(pmax, p0[r]);
#pragma unroll
        for (int r = 0; r < 16; ++r) pmax = fmaxf(pmax, p1[r]);
        { auto rr = __builtin_amdgcn_permlane32_swap(__float_as_uint(pmax), __float_as_uint(pmax), false, false); pmax = fmaxf(__uint_as_float(rr[0]), __uint_as_float(rr[1])); }
        const float mn = fmaxf(m_reg, pmax); const float alpha = __builtin_amdgcn_exp2f((m_reg - mn) * NSA_C); m_reg = mn;
        const float mnC = -mn * NSA_C;
        float ps = 0.f;
#pragma unroll
        for (int r = 0; r < 16; ++r) { p0[r] = __builtin_amdgcn_exp2f(fmaf(p0[r], NSA_C, mnC)); p1[r] = __builtin_amdgcn_exp2f(fmaf(p1[r], NSA_C, mnC)); ps += p0[r] + p1[r]; }
        { auto rr = __builtin_amdgcn_permlane32_swap(__float_as_uint(ps), __float_as_uint(ps), false, false); ps = __uint_as_float(rr[0]) + __uint_as_float(rr[1]); }
        l_reg = l_reg * alpha + ps;
        if (__any(alpha < 1.f)) { if (hi == 0) al_l[r32] = alpha; asm volatile("s_waitcnt lgkmcnt(0)" ::: "memory");
#pragma unroll
            for (int r = 0; r < 16; ++r) { const float al = al_l[crow(r, hi)]; o[0][r] *= al; o[1][r] *= al; } }
    }
    PK4(p0, 0, pa[0]); PK4(p0, 8, pa[1]); PK4(p1, 0, pa[2]); PK4(p1, 8, pa[3]);
    __builtin_amdgcn_sched_barrier(0);
    if (GRP == 1 || MODE != 3) {
#pragma unroll
        for (int d0 = 0; d0 < 2; ++d0)
#pragma unroll
            for (int ks = 0; ks < 4; ++ks) { const bf16x8 vf = tr_frag<2>(Vtrb, d0, ks); o[d0] = __builtin_amdgcn_mfma_f32_32x32x16_bf16(pa[ks], vf, o[d0], 0, 0, 0); }
    } else {
#pragma unroll
        for (int d0 = 0; d0 < 2; ++d0) { int nb = 64 * j + 8 * hi + 1 - 4 * (32 * d0 + r32); asm volatile("" : "+v"(nb));
#pragma unroll
            for (int ks = 0; ks < 4; ++ks) { bf16x8 of;
#pragma unroll
                for (int e = 0; e < 8; ++e) of[e] = ((unsigned)(nb + 16 * ks + e) <= 4u) ? (short)0x3F80 : (short)0;
                o[d0] = __builtin_amdgcn_mfma_f32_32x32x16_bf16(pa[ks], of, o[d0], 0, 0, 0); __builtin_amdgcn_sched_barrier(0); } }
    }
}

constexpr int NL_K = 0, NL_V = 16384, NL_IMP = 32768, NL_SEL = 49152, NL_UNI = 49152 + 512, NL_LIST = 49152 + 768, NL_WS = 51200;
#define NSA_LOAD(ksrc, vsrc) do { kreg = *(const bf16x8*)((ksrc) + tid * 8); vreg = *(const bf16x8*)((vsrc) + tid * 8); } while (0)
#define NSA_WRITE(buf) do { *(LAS bf16x8*)(lds + NL_K + (buf) * 8192 + KSWZ128(tid >> 3, (tid & 7) * 16)) = kreg; \
                            *(LAS bf16x8*)(lds + NL_V + (buf) * 8192 + tr_st<2>(tid >> 3, (tid & 7) * 8)) = vreg; } while (0)
__device__ __forceinline__ void nsa_final(const bool SET, f32x16 (&outa)[2], const f32x16& o0, const f32x16& o1, float (&invl)[16], float l_reg, LAS float* l_l, LAS const float* gsc, int br, int r32, int hi) {
    asm volatile("" : "+v"(gsc), "+v"(l_l));
    if (hi == 0) l_l[r32] = l_reg;
    asm volatile("s_waitcnt lgkmcnt(0)" ::: "memory");
#pragma unroll
    for (int r = 0; r < 16; ++r) { const float rl = l_l[crow(r, hi)]; invl[r] = rl > 0.f ? __builtin_amdgcn_rcpf(rl) : 0.f; }
    asm volatile("" ::: "memory");
#pragma unroll
    for (int r = 0; r < 16; ++r) { const float f = invl[r] * gsc[crow(r, hi) * 3 + br];
        if (SET) { outa[0][r] = o0[r] * f; outa[1][r] = o1[r] * f; } else { outa[0][r] += o0[r] * f; outa[1][r] += o1[r] * f; }
        if ((r & 3) == 3) asm volatile("" ::: "memory"); }
}
__device__ __forceinline__ void nsa_attn_unit(int unit, const bf16_t* NQp, const bf16_t* KV6p, const bf16_t* KCMPp, const float* NGp, bf16_t* YNSAp, LAS unsigned char* lds) {
    const int tid = opaque_tid(), lane = tid & 63, wave = __builtin_amdgcn_readfirstlane(tid >> 6), r32 = lane & 31, hi = lane >> 5;
    const int b = unit >> 7, qb = (unit >> 1) & 63, g = unit & 1;
    const int tl = 8 * wave + (r32 & 7), hh = r32 >> 3;
    const size_t tok = (size_t)b * SEQ + 64 * qb + tl;
    LAS float* wsf = (LAS float*)(lds + NL_WS + wave * 1024); LAS float* l_l = wsf; LAS float* al_l = wsf + 32; LAS float* gsc = wsf + 64;
    LAS float* impl = (LAS float*)(lds + NL_IMP); LAS unsigned* selm = (LAS unsigned*)(lds + NL_SEL); LAS int* slist = (LAS int*)(lds + NL_LIST);
    bf16x8 qr[4];
#pragma unroll
    for (int d0 = 0; d0 < 4; ++d0) qr[d0] = *(const bf16x8*)(NQp + tok * 512 + (4 * g + hh) * 64 + 16 * d0 + 8 * hi);
    if (hi == 0) { const float* gp = NGp + tok * 32 + (4 * g + hh) * 3; gsc[r32 * 3 + 0] = gp[0]; gsc[r32 * 3 + 1] = gp[1]; gsc[r32 * 3 + 2] = gp[2]; }
    const int rbv = tr_rd_base(lane);
    const size_t bg = (size_t)(b * 2 + g);
    bf16x8 kreg, vreg;
    f32x16 outa[2];
    {
        const bf16_t* Kc = KCMPp + bg * 256 * 64; const bf16_t* Vc = KCMPp + (size_t)(4096 * 64) + bg * 256 * 64;
        int nct = (4 * qb + 3 + 63) >> 6; if (nct > 4) nct = 4;
        f32x16 o2[2]; o2[0] = f32x16{}; o2[1] = f32x16{};
        float m_reg = -1.0e30f, l_reg = 0.f;
        NSA_LOAD(Kc, Vc); NSA_WRITE(0); __syncthreads();
#pragma unroll 1
        for (int i = 0; i < 2 * nct; ++i) {
            const int c = i < nct ? i : i - nct, i1 = i + 1, c1 = i1 < nct ? i1 : i1 - nct;
            if (i1 < 2 * nct) NSA_LOAD(Kc + c1 * 4096, Vc + c1 * 4096);
            if (i == nct) { float invl[16]; nsa_final(true, outa, o2[0], o2[1], invl, l_reg, l_l, gsc, 0, r32, hi); o2[0] = f32x16{}; o2[1] = f32x16{}; }
            nsa_tile<0>(i < nct ? 0 : 3, o2, m_reg, l_reg, lds + NL_K + (i & 1) * 8192, lds + NL_V + (i & 1) * 8192 + rbv, qr, al_l, r32, hi, qb, tl, c, true);
            if (i1 < 2 * nct) NSA_WRITE(i1 & 1);
            __syncthreads();
        }
        { LAS float* lp = l_l; asm volatile("" : "+v"(lp));
#pragma unroll
          for (int q = 0; q < 4; ++q) { float i0 = 0.f, i1 = 0.f;
#pragma unroll
            for (int h4 = 0; h4 < 4; ++h4) { const float rl = lp[crow(4 * h4 + q, hi)]; const float inv = rl > 0.f ? __builtin_amdgcn_rcpf(rl) : 0.f; i0 += o2[0][4 * h4 + q] * inv; i1 += o2[1][4 * h4 + q] * inv; }
            impl[(8 * wave + q + 4 * hi) * 64 + r32] = i0; impl[(8 * wave + q + 4 * hi) * 64 + 32 + r32] = i1; } }
    }
    __syncthreads();
    {
        const int tk = tid >> 3, jj = tid & 7; unsigned bits = 0u;
        float ev[8];
#pragma unroll
        for (int q = 0; q < 8; ++q) { const int j = jj * 8 + q; float v = impl[tk * 64 + j]; if (j == 0 || j == qb || j == qb - 1) v = 1.0e4f; if (j > qb) v = -1.0e4f; ev[q] = v; }
        int rank[8];
#pragma unroll
        for (int q = 0; q < 8; ++q) rank[q] = 0;
#pragma unroll 4
        for (int i = 0; i < 64; ++i) { float v = impl[tk * 64 + i]; if (i == 0 || i == qb || i == qb - 1) v = 1.0e4f; if (i > qb) v = -1.0e4f;
#pragma unroll
            for (int q = 0; q < 8; ++q) { const int j = jj * 8 + q; rank[q] += (v > ev[q] || (v == ev[q] && i < j)) ? 1 : 0; } }
#pragma unroll
        for (int q = 0; q < 8; ++q) bits |= (rank[q] < 16) ? (1u << q) : 0u;
        unsigned lo = (jj < 4) ? (bits << (8 * jj)) : 0u, hi32 = (jj >= 4) ? (bits << (8 * (jj - 4))) : 0u;
#pragma unroll
        for (int x = 1; x < 8; x <<= 1) { lo |= __shfl_xor(lo, x); hi32 |= __shfl_xor(hi32, x); }
        if (jj == 0) { selm[tk * 2] = lo; selm[tk * 2 + 1] = hi32; }
    }
    __syncthreads();
    if (wave == 0) { unsigned lo = selm[lane * 2], hi32 = selm[lane * 2 + 1];
#pragma unroll
        for (int x = 1; x < 64; x <<= 1) { lo |= __shfl_xor(lo, x); hi32 |= __shfl_xor(hi32, x); }
        if (lane == 0) { int cnt = 0; for (int j = 0; j <= qb; ++j) { const unsigned bit = (j < 32) ? (lo >> j) & 1u : (hi32 >> (j - 32)) & 1u; if (bit) slist[1 + cnt++] = j; } slist[0] = cnt; } }
    __syncthreads();
    const unsigned my_lo = selm[tl * 2], my_hi = selm[tl * 2 + 1];
    {
        const bf16_t* Ks = KV6p + 2 * KVSZ + bg * SEQ * 64; const bf16_t* Vs = KV6p + 3 * KVSZ + bg * SEQ * 64;
        const size_t wofs = 2 * KVSZ;
        const int ns = slist[0], j0 = qb >= 8 ? qb - 8 : 0, nw = qb - j0 + 1, ntot = ns + nw;
        f32x16 o2[2]; o2[0] = f32x16{}; o2[1] = f32x16{};
        float m_reg = -1.0e30f, l_reg = 0.f;
        int jn = slist[1];
        NSA_LOAD(Ks + (size_t)jn * 4096, Vs + (size_t)jn * 4096); NSA_WRITE(0); __syncthreads();
#pragma unroll 1
        for (int i = 0; i < ntot; ++i) {
            const int j = jn, i1 = i + 1;
            if (i1 < ntot) { const bool w1 = i1 >= ns; jn = w1 ? j0 + (i1 - ns) : slist[1 + i1]; const size_t so = (size_t)jn * 4096 + (w1 ? wofs : (size_t)0); NSA_LOAD(Ks + so, Vs + so); }
            if (i == ns) { float invl[16]; nsa_final(false, outa, o2[0], o2[1], invl, l_reg, l_l, gsc, 1, r32, hi); o2[0] = f32x16{}; o2[1] = f32x16{}; m_reg = -1.0e30f; l_reg = 0.f; }
            const bool selrow = ((j < 32) ? (my_lo >> j) : (my_hi >> (j - 32))) & 1u;
            nsa_tile<1>(i < ns ? 1 : 2, o2, m_reg, l_reg, lds + NL_K + (i & 1) * 8192, lds + NL_V + (i & 1) * 8192 + rbv, qr, al_l, r32, hi, qb, tl, j, selrow);
            if (i1 < ntot) NSA_WRITE(i1 & 1);
            __syncthreads();
        }
        float invl[16]; nsa_final(false, outa, o2[0], o2[1], invl, l_reg, l_l, gsc, 2, r32, hi);
    }
#pragma unroll
    for (int r = 0; r < 16; ++r) { const size_t t2 = (size_t)b * SEQ + 64 * qb + 8 * wave + (r & 3) + 4 * hi; bf16_t* p = YNSAp + t2 * 512 + (4 * g + (r >> 2)) * 64 + r32;
        p[0] = (bf16_t)f2bf(outa[0][r]); p[32] = (bf16_t)f2bf(outa[1][r]); }
    __syncthreads();
}

constexpr int LDS_BYTES = 147456;
constexpr int LDS_MISC = 131072;

struct Args {
    const float* in[24]; float* out; unsigned char* ws;
};

template <class RowFn>
__device__ __forceinline__ void transpose_item(const float* W, int K, int N, bf16_t* WT, int ldk, RowFn dst_row, LAS float* scr, int item, int lane) {
    const int nblk = (N + 31) / 32, kb = item / nblk, nb = item % nblk, k0 = 64 * kb, n0 = 32 * nb;
    const int ncol = n0 + (lane & 31);
#pragma unroll 8
    for (int i = 0; i < 32; ++i) { const int kk = 2 * i + (lane >> 5); scr[kk * 33 + (lane & 31)] = (ncol < N) ? W[(size_t)(k0 + kk) * N + ncol] : 0.f; }
    asm volatile("s_waitcnt lgkmcnt(0)" ::: "memory");
    const int c = lane & 7;
#pragma unroll
    for (int j = 0; j < 4; ++j) { const int n = (lane >> 3) + 8 * j; const LAS float* s = scr + (8 * c) * 33 + n;
        u32x4 o; o.x = pk2(s[0 * 33], s[1 * 33]); o.y = pk2(s[2 * 33], s[3 * 33]); o.z = pk2(s[4 * 33], s[5 * 33]); o.w = pk2(s[6 * 33], s[7 * 33]);
        if (n0 + n < N) *(u32x4*)(WT + (size_t)dst_row(n0 + n) * ldk + k0 + 8 * c) = o; }
    asm volatile("s_waitcnt lgkmcnt(0)" ::: "memory");
}
struct RowInProj { __device__ __forceinline__ int operator()(int c) const {
    int ht, p;
    if (c < 1024) { const int i = c & 127; ht = c >> 7; p = 32 * ((i >> 4) & 3) + 16 * (i >> 6) + 4 * ((i >> 2) & 3) + (i & 3); }
    else if (c < 3072) { ht = c >> 7; p = c & 127; }
    else if (c < 4352) { const int cc = c - 3072; ht = 24 + (cc >> 7); const int q = cc & 127;
        if (ht < 28 || ht == 28 || ht == 30 || ht == 32) { const int hin = q >> 6, i = q & 63, jj = i & 31; p = 32 * (2 * hin + (jj >> 4)) + 16 * (i >> 5) + 4 * ((jj >> 2) & 3) + (jj & 3); }
        else p = q; }
    else if (c < 4376) { ht = 34; p = c - 4352; }
    else { const int cc = c - 4376; ht = 35 + (cc >> 7); p = cc & 127; }
    return ht * 128 + p; } };
struct RowId { int off; __device__ __forceinline__ int operator()(int n) const { return off + n; } };
struct RowE13 { int ex, which; __device__ __forceinline__ int operator()(int c) const {
    const int pn = c >> 7, cc = c & 127, bj = cc >> 6, wc = (cc >> 4) & 3, fq = (cc >> 2) & 3, e = cc & 3;
    return ex * 512 + 256 * pn + 128 * bj + 32 * wc + 16 * which + 4 * fq + e; } };

__global__ void __launch_bounds__(NTHREADS, 2) mega_fwd(Args a) {
    extern __shared__ __attribute__((aligned(16))) unsigned char lds_raw[];
    LAS unsigned char* lds = (LAS unsigned char*)lds_raw;
    cg::grid_group grid = cg::this_grid();
    const int G = gridDim.x, blk = blockIdx.x, NGW = G * NWAVES;
#define PHASE_IDS const int tid = opaque_tid(), lane = tid & 63, wave = __builtin_amdgcn_readfirstlane(tid >> 6), gw = blk * NWAVES + wave; (void)lane; (void)gw
#define ws (a.ws)
#define X_IN (a.in[0])
#define cvec (a.in[1])
#define w_ada (a.in[2])
#define b_ada (a.in[3])
#define w_in (a.in[4])
#define cmp_pos_k (a.in[5])
#define cmp_pos_v (a.in[6])
#define w_cmp_k (a.in[7])
#define w_cmp_v (a.in[8])
#define w_ret_out (a.in[9])
#define w_nsa_out (a.in[10])
#define w_out (a.in[11])
#define ln1_g (a.in[12])
#define ln1_b (a.in[13])
#define w_router (a.in[14])
#define b_router (a.in[15])
#define w_e1 (a.in[16])
#define w_e3 (a.in[17])
#define w_e2 (a.in[18])
#define w_s1 (a.in[19])
#define w_s3 (a.in[20])
#define w_s2 (a.in[21])
#define ln2_g (a.in[22])
#define ln2_b (a.in[23])
#define OUT_P (a.out)
#define ctl ((unsigned*)(ws + WS_CTL))
#define MOD ((float*)(ws + WS_MOD))
#define WRT ((bf16_t*)(ws + WS_WRT))
#define E13 ((bf16_t*)(ws + WS_E13))
#define E2 ((bf16_t*)(ws + WS_E2))
#define Hb ((bf16_t*)(ws + WS_H))
#define LOGITS ((float*)(ws + WS_LOGITS))
#define EIDX ((int*)(ws + WS_EIDX))
#define WSEL ((float*)(ws + WS_WSEL))
#define LRANK ((int*)(ws + WS_LRANK))
#define BBASE ((int*)(ws + WS_BBASE))
#define ROWTOK ((int*)(ws + WS_ROWTOK))
#define DEST ((int*)(ws + WS_DEST))
#define TILEE ((int*)(ws + WS_TILEE))
#define Gb ((bf16_t*)(ws + WS_G))
#define Yb ((bf16_t*)(ws + WS_Y))
#define WIN ((bf16_t*)(ws + WS_WIN))
#define WRET ((bf16_t*)(ws + WS_WRET))
#define WNSA ((bf16_t*)(ws + WS_WNSA))
#define WOUT ((bf16_t*)(ws + WS_WOUT))
#define WCK ((bf16_t*)(ws + WS_WCK))
#define WCV ((bf16_t*)(ws + WS_WCV))
#define KCMP ((bf16_t*)(ws + WS_KCMP))
#define CBIAS ((float*)(ws + WS_CBIAS))
#define Ub ((bf16_t*)(ws + WS_U))
#define RQ ((bf16_t*)(ws + WS_RQ))
#define RK ((bf16_t*)(ws + WS_RK))
#define RV ((bf16_t*)(ws + WS_RV))
#define RG ((bf16_t*)(ws + WS_RG))
#define NQ ((bf16_t*)(ws + WS_NQ))
#define KV6 ((bf16_t*)(ws + WS_KV6))
#define NG ((float*)(ws + WS_NG))
#define MR ((bf16_t*)(ws + WS_MR))
#define MN ((bf16_t*)(ws + WS_MN))
#define KVS ((float*)(ws + WS_KVS))
#define PREV ((bf16_t*)(ws + WS_PREV))
#define YRET ((bf16_t*)(ws + WS_YRET))
#define YNSA ((bf16_t*)(ws + WS_YNSA))
#define T1 ((bf16_t*)(ws + WS_T1))
#define MG ((bf16_t*)(ws + WS_MG))
    {
        PHASE_IDS;
        LAS float* cond = (LAS float*)lds;
        LAS float* red = (LAS float*)(lds + 32768);
        bool have_cond = false;
        for (int it = blk; it < 96; it += G) {
            if (!have_cond) { for (int i = tid; i < 8 * 1024; i += NTHREADS) cond[i] = siluf_(cvec[i]); __syncthreads(); have_cond = true; }
            const int col = it * 64 + lane;
            float accb[8];
#pragma unroll
            for (int b = 0; b < 8; ++b) accb[b] = 0.f;
            const int kbeg = wave * 128;
#pragma unroll 8
            for (int k = kbeg; k < kbeg + 128; ++k) { const float wv = w_ada[(size_t)k * 6144 + col];
#pragma unroll
                for (int b = 0; b < 8; ++b) accb[b] += cond[b * 1024 + k] * wv; }
#pragma unroll
            for (int b = 0; b < 8; ++b) red[(wave * 8 + b) * 64 + lane] = accb[b];
            __syncthreads();
            { const int b = tid >> 6; float s = 0.f;
#pragma unroll
              for (int w = 0; w < 8; ++w) s += red[(w * 8 + b) * 64 + lane];
              MOD[b * 6144 + it * 64 + lane] = s + b_ada[it * 64 + lane]; }
            __syncthreads();
        }
        __syncthreads();
        LAS float* scr = (LAS float*)(lds + wave * 16384);
        constexpr int I_IN = 16 * 201, I_RET = 16 * 32, I_NSA = 8 * 32, I_OUT = 16 * 32, I_RT = 16 * 8, I_CMP = 32 * 2;
        for (int it = gw; it < I_IN + I_RET + I_NSA + I_OUT + I_RT + 2 * I_CMP; it += NGW) {
            int r = it;
            if (r < I_IN) { transpose_item(w_in, 1024, DIN, WIN, 1024, RowInProj{}, scr, r, lane); continue; } r -= I_IN;
            if (r < I_RET) { transpose_item(w_ret_out, 1024, 1024, WRET, 1024, RowId{0}, scr, r, lane); continue; } r -= I_RET;
            if (r < I_NSA) { transpose_item(w_nsa_out, 512, 1024, WNSA, 512, RowId{0}, scr, r, lane); continue; } r -= I_NSA;
            if (r < I_OUT) { transpose_item(w_out, 1024, 1024, WOUT, 1024, RowId{0}, scr, r, lane); continue; } r -= I_OUT;
            if (r < I_RT) { transpose_item(w_router, 1024, 256, WRT, 1024, RowId{0}, scr, r, lane); continue; } r -= I_RT;
            if (r < I_CMP) { transpose_item(w_cmp_k, 2048, 64, WCK, 2048, RowId{0}, scr, r, lane); continue; } r -= I_CMP;
            transpose_item(w_cmp_v, 2048, 64, WCV, 2048, RowId{0}, scr, r, lane);
        }
        if (gw < 2) {
            const float* pos = gw ? cmp_pos_v : cmp_pos_k; const float* wc_ = gw ? w_cmp_v : w_cmp_k; float sacc = 0.f;
            for (int k = 0; k < 2048; ++k) sacc += pos[k] * wc_[k * 64 + lane];
            CBIAS[gw * 64 + lane] = sacc;
        }
    }
    grid.sync();

    { PHASE_IDS;
    for (int m = gw; m < NTOK; m += NGW) {
        const int b = m / SEQ; const float* mod = MOD + b * 6144;
        const f32x4* xr = (const f32x4*)(X_IN + (size_t)m * DM) + lane;
        f32x4 v[4]; float s = 0.f;
#pragma unroll
        for (int j = 0; j < 4; ++j) { v[j] = xr[64 * j]; s += (v[j].x + v[j].y) + (v[j].z + v[j].w); }
        const float mean = wave_sum(s) * (1.f / DM); float s2 = 0.f;
#pragma unroll
        for (int j = 0; j < 4; ++j) { v[j] = v[j] - mean; s2 += (v[j].x * v[j].x + v[j].y * v[j].y) + (v[j].z * v[j].z + v[j].w * v[j].w); }
        const float rstd = 1.f / sqrtf(wave_sum(s2) * (1.f / DM) + LN_EPS);
        u32x2* o8 = (u32x2*)(Ub + (size_t)m * DM) + lane;
#pragma unroll
        for (int j = 0; j < 4; ++j) { const f32x4 sh = *((const f32x4*)(mod) + lane + 64 * j), sc = *((const f32x4*)(mod + 1024) + lane + 64 * j);
            const f32x4 hv = v[j] * rstd * (sc + 1.0f) + sh; u32x2 w; w.x = pk2(hv.x, hv.y); w.y = pk2(hv.z, hv.w); o8[64 * j] = w; }
    } }
    grid.sync();

    {
        pg8::Gemm g{Ub, WIN, 1024, nullptr}; pg8::StaticOrder S; S.init(NTOK, DIN_PAD, G, blk);
        pg8::EpiInProj E{ws};
        pg8::gemm_phase<pg8::EpiInProj, pg8::StaticOrder, false>(lds, g, S, E);
    }
    grid.sync();

    for (int unit = blk; unit < 256; unit += G) nsa_cmp_unit(unit, KV6, WCK, CBIAS, KCMP, lds);
    for (int unit = blk; unit < 1024; unit += G) { if (((unit >> 2) & 31) == 31) continue; ret_kv_unit(unit, RK, RV, KVS, lds); }
    grid.sync();

    { PHASE_IDS;
    for (int idx8 = blk * NTHREADS + tid; idx8 < 131072; idx8 += G * NTHREADS) {
        const int bh = idx8 >> 12, b = bh >> 2, h = bh & 3; const size_t off = (size_t)(idx8 & 4095) * 8;
        const float dC = __builtin_amdgcn_exp2f(128.0f * ret_log2gamma(h));
        float st[8];
#pragma unroll
        for (int i = 0; i < 8; ++i) st[i] = 0.f;
        for (int n = 0; n < 32; ++n) { const size_t uo = (size_t)((b * 32 + n) * 4 + h) * 32768 + off;
            u32x4 w; w.x = pk2(st[0], st[1]); w.y = pk2(st[2], st[3]); w.z = pk2(st[4], st[5]); w.w = pk2(st[6], st[7]); *(u32x4*)(PREV + uo) = w;
            if (n < 31) { const f32x4 k0 = *(const f32x4*)(KVS + uo), k1 = *(const f32x4*)(KVS + uo + 4);
                st[0] = st[0] * dC + k0.x; st[1] = st[1] * dC + k0.y; st[2] = st[2] * dC + k0.z; st[3] = st[3] * dC + k0.w;
                st[4] = st[4] * dC + k1.x; st[5] = st[5] * dC + k1.y; st[6] = st[6] * dC + k1.z; st[7] = st[7] * dC + k1.w; } }
    } }
    grid.sync();

    for (int unit = blk; unit < 1024; unit += G) ret_out_unit(unit, RQ, RK, RV, RG, PREV, YRET, lds);
    { int it = 0; for (int idx = blk; idx < 1024; idx += G, ++it) { const int qb0 = (idx >> 1) & 63;
        nsa_attn_unit((idx & ~126) | (((it & 1) ? 63 - qb0 : qb0) << 1), NQ, KV6, KCMP, NG, YNSA, lds); } }
    grid.sync();

    {
        pg8::Gemm g{YRET, WRET, 1024, nullptr}; pg8::StaticOrder S; S.init(NTOK, 1024, G, blk);
        pg8::EpiGate E{T1, MR, nullptr};
        pg8::gemm_phase<pg8::EpiGate, pg8::StaticOrder, false>(lds, g, S, E);
    }
    {
        pg8::Gemm g{YNSA, WNSA, 512, nullptr}; pg8::StaticOrder S; S.init(NTOK, 1024, G, blk);
        pg8::EpiGate E{MG, MN, T1};
        pg8::gemm_phase<pg8::EpiGate, pg8::StaticOrder, false>(lds, g, S, E);
    }
    grid.sync();
    {
        pg8::Gemm g{MG, WOUT, 1024, nullptr}; pg8::StaticOrder S; S.init(NTOK, 1024, G, blk);
        pg8::EpiResid E{OUT_P, X_IN, MOD};
        pg8::gemm_phase<pg8::EpiResid, pg8::StaticOrder, false>(lds, g, S, E);
    }
    grid.sync();

    { PHASE_IDS;
    for (int m = gw; m < NTOK; m += NGW) {
        const int b = m / SEQ; const float* mod = MOD + b * 6144;
        const f32x4* xr = (const f32x4*)(OUT_P + (size_t)m * DM) + lane;
        f32x4 v[4]; float s = 0.f;
#pragma unroll
        for (int j = 0; j < 4; ++j) { v[j] = xr[64 * j]; s += (v[j].x + v[j].y) + (v[j].z + v[j].w); }
        float mean = wave_sum(s) * (1.f / DM); float s2 = 0.f;
#pragma unroll
        for (int j = 0; j < 4; ++j) { v[j] = v[j] - mean; s2 += (v[j].x * v[j].x + v[j].y * v[j].y) + (v[j].z * v[j].z + v[j].w * v[j].w); }
        float rstd = 1.f / sqrtf(wave_sum(s2) * (1.f / DM) + LN_EPS);
        s = 0.f;
#pragma unroll
        for (int j = 0; j < 4; ++j) { const f32x4 gg = *((const f32x4*)ln1_g + lane + 64 * j), bb = *((const f32x4*)ln1_b + lane + 64 * j);
            v[j] = v[j] * rstd * gg + bb; *((f32x4*)(OUT_P + (size_t)m * DM) + lane + 64 * j) = v[j]; s += (v[j].x + v[j].y) + (v[j].z + v[j].w); }
        mean = wave_sum(s) * (1.f / DM); s2 = 0.f;
#pragma unroll
        for (int j = 0; j < 4; ++j) { v[j] = v[j] - mean; s2 += (v[j].x * v[j].x + v[j].y * v[j].y) + (v[j].z * v[j].z + v[j].w * v[j].w); }
        rstd = 1.f / sqrtf(wave_sum(s2) * (1.f / DM) + LN_EPS);
        u32x2* o8 = (u32x2*)(Hb + (size_t)m * DM) + lane;
#pragma unroll
        for (int j = 0; j < 4; ++j) { const f32x4 sh = *((const f32x4*)(mod + 3 * 1024) + lane + 64 * j), sc = *((const f32x4*)(mod + 4 * 1024) + lane + 64 * j);
            const f32x4 hv = v[j] * rstd * (sc + 1.0f) + sh; u32x2 w; w.x = pk2(hv.x, hv.y); w.y = pk2(hv.z, hv.w); o8[64 * j] = w; }
    } }
    grid.sync();

    {
        pg8::Gemm g{Hb, WRT, 1024, nullptr}; pg8::StaticOrder S; S.init(NTOK, 256, G, blk);
        pg8::EpiF32 E{LOGITS, 256};
        pg8::gemm_phase<pg8::EpiF32, pg8::StaticOrder, false>(lds, g, S, E);
        __syncthreads();
        PHASE_IDS;
        LAS float* scr = (LAS float*)(lds + wave * 16384);
        constexpr int I13 = 16 * 8, I2 = 4 * 32;
        for (int it = gw; it < 257 * (2 * I13 + I2); it += NGW) {
            const int ex = it / (2 * I13 + I2); int r = it % (2 * I13 + I2);
            if (r < I13) { transpose_item(ex < 256 ? w_e1 + (size_t)ex * 1024 * 256 : w_s1, 1024, 256, E13, 1024, RowE13{ex, 0}, scr, r, lane); continue; } r -= I13;
            if (r < I13) { transpose_item(ex < 256 ? w_e3 + (size_t)ex * 1024 * 256 : w_s3, 1024, 256, E13, 1024, RowE13{ex, 1}, scr, r, lane); continue; } r -= I13;
            transpose_item(ex < 256 ? w_e2 + (size_t)ex * 256 * 1024 : w_s2, 256, 1024, E2, 256, RowId{ex * 1024}, scr, r, lane);
        }
    }
    grid.sync();

    {
        PHASE_IDS;
        LAS unsigned* cntl = (LAS unsigned*)lds;
        for (int tb = blk; tb < NTOK / 128; tb += G) {
            if (tid < 256) cntl[tid] = 0u;
            __syncthreads();
            for (int tl = wave; tl < 128; tl += NWAVES) {
                const int tok = tb * 128 + tl;
                const f32x4 lg = *((const f32x4*)(LOGITS + (size_t)tok * 256) + lane);
                const f32x4 br = *((const f32x4*)b_router + lane);
                float sv[4];
                sv[0] = sigmoidf_(lg.x) + br.x; sv[1] = sigmoidf_(lg.y) + br.y; sv[2] = sigmoidf_(lg.z) + br.z; sv[3] = sigmoidf_(lg.w) + br.w;
                float m1 = fmaxf(sv[0], sv[1]), m2 = fminf(sv[0], sv[1]);
                { const float c = sv[2]; const float n1 = fmaxf(m1, c); m2 = fmaxf(fminf(m1, c), m2); m1 = n1; }
                { const float c = sv[3]; const float n1 = fmaxf(m1, c); m2 = fmaxf(fminf(m1, c), m2); m1 = n1; }
#pragma unroll
                for (int o = 1; o < 8; o <<= 1) { const float o1 = __shfl_xor(m1, o), o2 = __shfl_xor(m2, o); const float n1 = fmaxf(m1, o1); m2 = fmaxf(fminf(m1, o1), fmaxf(m2, o2)); m1 = n1; }
                const float gs = m1 + m2; const int myg = lane >> 3; int rank = 0;
#pragma unroll
                for (int gq = 0; gq < 8; ++gq) { const float og = __shfl(gs, gq * 8); rank += (og > gs || (og == gs && gq < myg)) ? 1 : 0; }
                const bool keep = rank < 4;
                unsigned long long key[4];
#pragma unroll
                for (int i = 0; i < 4; ++i) { const float sc = keep ? sv[i] : -1.0e30f; unsigned ub = __builtin_bit_cast(unsigned, sc); ub = (ub & 0x80000000u) ? ~ub : (ub | 0x80000000u);
                    key[i] = ((unsigned long long)ub << 8) | (unsigned long long)(255 - (lane * 4 + i)); }
                int my_e = 0;
#pragma unroll 1
                for (int k = 0; k < TOPK; ++k) {
                    unsigned long long best = key[0]; best = key[1] > best ? key[1] : best; best = key[2] > best ? key[2] : best; best = key[3] > best ? key[3] : best;
#pragma unroll
                    for (int o = 1; o < 64; o <<= 1) { const unsigned lo = __shfl_xor((unsigned)best, o), hi = __shfl_xor((unsigned)(best >> 32), o);
                        const unsigned long long ob = ((unsigned long long)hi << 32) | lo; best = ob > best ? ob : best; }
                    const int e = 255 - (int)(best & 0xffull);
                    if (lane == k) my_e = e;
#pragma unroll
                    for (int i = 0; i < 4; ++i) if (lane * 4 + i == e) key[i] = 0ull;
                }
                float aff = 0.f;
                if (lane < TOPK) aff = sigmoidf_(LOGITS[(size_t)tok * 256 + my_e]);
                float asum = aff;
#pragma unroll
                for (int o = 1; o < 8; o <<= 1) asum += __shfl_xor(asum, o);
                if (lane < TOPK) {
                    const unsigned lr = __hip_atomic_fetch_add(cntl + my_e, 1u, __ATOMIC_RELAXED, __HIP_MEMORY_SCOPE_WORKGROUP);
                    EIDX[tok * 8 + lane] = my_e; WSEL[tok * 8 + lane] = aff / asum * ROUTED_SCALE; LRANK[tok * 8 + lane] = (int)lr;
                }
            }
            __syncthreads();
            if (tid < 256) BBASE[tb * 256 + tid] = (int)atomicAdd(ctl + tid, cntl[tid]);
            __syncthreads();
        }
    }
    grid.sync();

    {
        PHASE_IDS;
        LAS int* pad = (LAS int*)lds; LAS int* ps = (LAS int*)(lds + 1024); LAS int* cn = (LAS int*)(lds + 2048);
        if (tid < 256) { const int c = (int)__hip_atomic_load(ctl + tid, __ATOMIC_RELAXED, __HIP_MEMORY_SCOPE_AGENT); cn[tid] = c; pad[tid] = (c + 255) & ~255; }
        __syncthreads();
        if (tid < 256) { int s = 0; for (int j = 0; j < tid; ++j) s += pad[j]; ps[tid] = s; }
        __syncthreads();
        const int p_routed = ps[255] + pad[255];
        for (int tb = blk; tb < NTOK / 128; tb += G) {
            for (int aidx = tid; aidx < 1024; aidx += NTHREADS) { const int tok = tb * 128 + (aidx >> 3), k = aidx & 7; const int e = EIDX[tok * 8 + k];
                const int slot = ps[e] + BBASE[tb * 256 + e] + LRANK[tok * 8 + k]; ROWTOK[slot] = tok; DEST[slot] = tok * 9 + k; }
            if (tid < 128) { const int tok = tb * 128 + tid; ROWTOK[p_routed + tok] = tok; DEST[p_routed + tok] = tok * 9 + 8; }
        }
        for (int e = blk; e < NEXP; e += G) {
            for (int r = cn[e] + tid; r < pad[e]; r += NTHREADS) { ROWTOK[ps[e] + r] = 0; DEST[ps[e] + r] = -1; }
            for (int j = tid; j < pad[e] / 256; j += NTHREADS) TILEE[ps[e] / 256 + j] = e;
        }
        for (int j = blk * NTHREADS + tid; j < NTOK / 256; j += G * NTHREADS) TILEE[p_routed / 256 + j] = 256;
        if (blk == 0 && tid == 0) ctl[256] = (unsigned)(p_routed / 256 + NTOK / 256);
        __syncthreads();
    }
    grid.sync();

    const int ntiles = (int)__hip_atomic_load(ctl + 256, __ATOMIC_RELAXED, __HIP_MEMORY_SCOPE_AGENT);
    {
        pg8::Gemm g{Hb, E13, 1024, ROWTOK}; pg8::MoeOrder S{TILEE, ntiles, 2, G, blk};
        pg8::EpiSwiGlu E{Gb};
        pg8::gemm_phase<pg8::EpiSwiGlu, pg8::MoeOrder, true>(lds, g, S, E);
    }
    grid.sync();
    {
        pg8::Gemm g{Gb, E2, 256, nullptr}; pg8::MoeOrder S{TILEE, ntiles, 4, G, blk};
        pg8::EpiScatter E{Yb, DEST};
        pg8::gemm_phase<pg8::EpiScatter, pg8::MoeOrder, false>(lds, g, S, E);
    }
    grid.sync();

    { PHASE_IDS;
    for (int m = gw; m < NTOK; m += NGW) {
        const int b = m / SEQ; const float* mod = MOD + b * 6144;
        float wk[8];
#pragma unroll
        for (int k = 0; k < 8; ++k) wk[k] = WSEL[m * 8 + k];
        f32x4 v[4]; float s = 0.f;
#pragma unroll
        for (int j = 0; j < 4; ++j) {
            f32x4 y = (f32x4){0.f, 0.f, 0.f, 0.f};
#pragma unroll
            for (int k = 0; k < 9; ++k) { const u32x2 w = *((const u32x2*)(Yb + ((size_t)m * 9 + k) * DM) + lane + 64 * j); const float wt = (k < 8) ? wk[k & 7] : 1.0f;
                y.x += wt * bf_lo(w.x); y.y += wt * bf_hi(w.x); y.z += wt * bf_lo(w.y); y.w += wt * bf_hi(w.y); }
            const f32x4 g2 = *((const f32x4*)(mod + 5 * 1024) + lane + 64 * j);
            const f32x4 x1 = *((const f32x4*)(OUT_P + (size_t)m * DM) + lane + 64 * j);
            v[j] = x1 * ALPHA + (g2 + 1.0f) * y; s += (v[j].x + v[j].y) + (v[j].z + v[j].w);
        }
        const float mean = wave_sum(s) * (1.f / DM); float s2 = 0.f;
#pragma unroll
        for (int j = 0; j < 4; ++j) { v[j] = v[j] - mean; s2 += (v[j].x * v[j].x + v[j].y * v[j].y) + (v[j].z * v[j].z + v[j].w * v[j].w); }
        const float rstd = 1.f / sqrtf(wave_sum(s2) * (1.f / DM) + LN_EPS);
#pragma unroll
        for (int j = 0; j < 4; ++j) { const f32x4 gg = *((const f32x4*)ln2_g + lane + 64 * j), bb = *((const f32x4*)ln2_b + lane + 64 * j);
            *((f32x4*)(OUT_P + (size_t)m * DM) + lane + 64 * j) = v[j] * rstd * gg + bb; }
    } }
}

#undef ws
#undef X_IN
#undef cvec
#undef w_ada
#undef b_ada
#undef w_in
#undef cmp_pos_k
#undef cmp_pos_v
#undef w_cmp_k
#undef w_cmp_v
#undef w_ret_out
#undef w_nsa_out
#undef w_out
#undef ln1_g
#undef ln1_b
#undef w_router
#undef b_router
#undef w_e1
#undef w_e3
#undef w_e2
#undef w_s1
#undef w_s3
#undef w_s2
#undef ln2_g
#undef ln2_b
#undef OUT_P
#undef ctl
#undef MOD
#undef WRT
#undef E13
#undef E2
#undef Hb
#undef LOGITS
#undef EIDX
#undef WSEL
#undef LRANK
#undef BBASE
#undef ROWTOK
#undef DEST
#undef TILEE
#undef Gb
#undef Yb
#undef WIN
#undef WRET
#undef WNSA
#undef WOUT
#undef WCK
#undef WCV
#undef KCMP
#undef CBIAS
#undef Ub
#undef RQ
#undef RK
#undef RV
#undef RG
#undef NQ
#undef KV6
#undef NG
#undef MR
#undef MN
#undef KVS
#undef PREV
#undef YRET
#undef YNSA
#undef T1
#undef MG
extern "C" void kernel_launch(void* const* d_in, const int* in_sizes, int n_in, void* d_out, int out_size, void* d_ws, size_t ws_size, hipStream_t stream) {
    static int grid = 0;
    if (grid == 0) {
        if (n_in != 24 || out_size != NTOK * DM || ws_size < WS_END) { fprintf(stderr, "kernel_launch: unexpected shapes (n_in %d out %d ws %zu, need ws >= %zu)\n", n_in, out_size, ws_size, (size_t)WS_END); grid = -1; return; }
        int dev = 0, cus = 0, per_cu = 0;
        hipGetDevice(&dev);
        hipDeviceGetAttribute(&cus, hipDeviceAttributeMultiprocessorCount, dev);
        if (hipFuncSetAttribute((const void*)mega_fwd, hipFuncAttributeMaxDynamicSharedMemorySize, LDS_BYTES) != hipSuccess) { fprintf(stderr, "kernel_launch: hipFuncSetAttribute failed\n"); grid = -1; return; }
        if (hipOccupancyMaxActiveBlocksPerMultiprocessor(&per_cu, (const void*)mega_fwd, NTHREADS, LDS_BYTES) != hipSuccess || per_cu < 1) { fprintf(stderr, "kernel_launch: occupancy query says %d blocks per CU\n", per_cu); grid = -1; return; }
        grid = cus;
    }
    if (grid < 0) return;
    hipMemsetAsync((char*)d_ws + WS_CTL, 0, CTL_BYTES, stream);
    Args a{};
    for (int i = 0; i < 24; ++i) a.in[i] = (const float*)d_in[i];
    a.out = (float*)d_out; a.ws = (unsigned char*)d_ws;
    void* args[] = {&a};
    hipError_t e = hipLaunchCooperativeKernel((const void*)mega_fwd, dim3(grid), dim3(NTHREADS), args, LDS_BYTES, stream);
    if (e != hipSuccess) fprintf(stderr, "kernel_launch: cooperative launch failed: %s (grid %d)\n", hipGetErrorString(e), grid);
}
```

```cpp
#include <hip/hip_runtime.h>
#include <hip/hip_cooperative_groups.h>
#include <cstdio>
#include <cstdint>
namespace cg = cooperative_groups;

#define LAS __attribute__((address_space(3)))
typedef unsigned short bf16_t;
typedef short bf16x8 __attribute__((ext_vector_type(8)));
typedef short s16x4 __attribute__((ext_vector_type(4)));
typedef float f32x4 __attribute__((ext_vector_type(4)));
typedef float f32x2 __attribute__((ext_vector_type(2)));
typedef float f32x16 __attribute__((ext_vector_type(16)));
typedef unsigned u32x4 __attribute__((ext_vector_type(4)));
typedef unsigned u32x2 __attribute__((ext_vector_type(2)));

constexpr int BATCH = 8, SEQ = 4096, DM = 1024, NTOK = BATCH * SEQ;
constexpr int NEXP = 256, TOPK = 8, DEXP = 256;
constexpr int DIN = 6424, DIN_PAD = 6656;
constexpr float LN_EPS = 1e-5f;
constexpr float ALPHA = 1.189207115002721f;
constexpr float ROUTED_SCALE = 2.5f;
constexpr int NWAVES = 8, NTHREADS = 512;

constexpr size_t MiB = 1u << 20, KiB = 1u << 10;
constexpr size_t WS_CTL = 0, CTL_BYTES = 64 * KiB;
constexpr size_t WS_MOD = 64 * KiB;
constexpr size_t WS_CBIAS = 256 * KiB;
constexpr size_t WS_WRT = 1 * MiB;
constexpr size_t WS_WCK = 1 * MiB + 512 * KiB, WS_WCV = 1 * MiB + 768 * KiB;
constexpr size_t WS_WRET = 2 * MiB, WS_WNSA = 4 * MiB, WS_WOUT = 5 * MiB;
constexpr size_t WS_KCMP = 7 * MiB, WS_VCMP = 7 * MiB + 512 * KiB;
constexpr size_t WS_EIDX = 8 * MiB, WS_WSEL = 9 * MiB, WS_LRANK = 10 * MiB, WS_BBASE = 11 * MiB;
constexpr size_t WS_ROWTOK = 12 * MiB, WS_DEST = 14 * MiB, WS_TILEE = 16 * MiB;
constexpr size_t WS_WIN = 17 * MiB;
constexpr size_t WS_E2 = 32 * MiB;
constexpr size_t WS_G = 161 * MiB;
constexpr size_t WS_E13 = 337 * MiB;
constexpr size_t WS_H = 594 * MiB;
constexpr size_t WS_LOGITS = 658 * MiB;
constexpr size_t WS_Y = 337 * MiB;
constexpr int MAX_TILES = 1279 + 128, P_MAX = MAX_TILES * 256;
constexpr size_t WS_U = 32 * MiB;
constexpr size_t WS_RQ = 96 * MiB, WS_RK = 128 * MiB, WS_RV = 160 * MiB, WS_RG = 224 * MiB, WS_NQ = 288 * MiB;
constexpr size_t WS_KV6 = 320 * MiB;
constexpr size_t KVSZ = (size_t)BATCH * 2 * SEQ * 64;
constexpr size_t WS_NG = 368 * MiB;
constexpr size_t WS_MR = 372 * MiB, WS_MN = 436 * MiB;
constexpr size_t WS_KVS = 500 * MiB;
constexpr size_t WS_PREV = 628 * MiB;
constexpr size_t WS_YRET = 692 * MiB, WS_YNSA = 756 * MiB, WS_T1 = 788 * MiB, WS_MG = 852 * MiB;
constexpr size_t WS_END = 916 * MiB;

__device__ __forceinline__ unsigned f2bf(float f) { unsigned u = __builtin_bit_cast(unsigned, f); return (u + 0x7fffu + ((u >> 16) & 1u)) >> 16; }
__device__ __forceinline__ unsigned pk2(float lo, float hi) { return f2bf(lo) | (f2bf(hi) << 16); }
__device__ __forceinline__ float bf_lo(unsigned w) { return __builtin_bit_cast(float, w << 16); }
__device__ __forceinline__ float bf_hi(unsigned w) { return __builtin_bit_cast(float, w & 0xffff0000u); }
__device__ __forceinline__ float wave_sum(float v) {
#pragma unroll
    for (int o = 1; o < 64; o <<= 1) v += __shfl_xor(v, o);
    return v;
}
__device__ __forceinline__ int opaque_tid() { int t = threadIdx.x; asm volatile("" : "+v"(t)); return t; }
__device__ __forceinline__ float sigmoidf_(float x) { return 1.0f / (1.0f + __expf(-x)); }
__device__ __forceinline__ float siluf_(float x) { return x / (1.0f + __expf(-x)); }

namespace pg8 {
constexpr int BM = 256, BK = 64, HALF = 128, HTB = HALF * BK * 2, STAGE_BYTES = 8 * HTB, NXCD = 8, WGM = 8;
__host__ __device__ __forceinline__ int lds_byte(int r, int c) { const int st = (r >> 4) * 2 + (c >> 5), rr = r & 15, cc = c & 31, ob = rr * 64 + cc * 2; return st * 1024 + (ob ^ (((ob >> 9) & 1) << 5)); }
__host__ __device__ __forceinline__ void stage_rc(int b, int& R, int& C) { const int st = b / 1024, sb = b % 1024, swz = sb ^ (((sb >> 9) & 1) << 5); R = (st >> 1) * 16 + swz / 64; C = (st & 1) * 32 + (swz % 64) / 2; }

struct Unit { int pm, pn, pb; };
struct Gemm { const bf16_t* A; const bf16_t* Bt; int K; const int* rows; };

struct StaticOrder {
    int nM, nN, nwg, G, c;
    __device__ void init(int M, int N, int G_, int c_) { nM = M / BM; nN = N / BM; nwg = nM * nN; G = G_; c = c_; }
    __device__ bool next(int i, Unit& u) const {
        const long L = (long)i * G + c; if (L >= nwg) return false;
        int wgid = (int)L; { const int q = nwg / NXCD, r = nwg % NXCD, xcd = wgid % NXCD, off = wgid / NXCD; wgid = (xcd < r ? xcd * (q + 1) : r * (q + 1) + (xcd - r) * q) + off; }
        const int nig = WGM * nN, gid = wgid / nig, fm = gid * WGM, gsz = (nM - fm) < WGM ? (nM - fm) : WGM;
        u.pm = fm + ((wgid % nig) % gsz); u.pn = (wgid % nig) / gsz; u.pb = u.pn; return true;
    }
};
struct MoeOrder {
    const int* tile_e; int ntiles, NC, G, c;
    __device__ bool next(int i, Unit& u) const {
        const int cx = (G % 8 == 0) ? (c % 8) * (G / 8) + c / 8 : c;
        const long L = (long)i * G + cx; if (L >= (long)ntiles * NC) return false;
        u.pm = (int)(L / NC); u.pn = (int)(L % NC); u.pb = tile_e[u.pm] * NC + u.pn; return true;
    }
};

template <class Epi, class Sched, bool GATHER>
__device__ __forceinline__ void gemm_phase(LAS unsigned char* lds, const Gemm g, const Sched& S, const Epi& E) {
    const int tid = opaque_tid(), wid = __builtin_amdgcn_readfirstlane(tid >> 6), lane = tid & 63, wr = wid >> 2, wc = wid & 3, fr = lane & 15, fq = lane >> 4;
    const int K = g.K, nt = K / BK;
    unsigned voffA[2], voffB[2]; int RA[2]; unsigned CA[2];
#pragma unroll
    for (int i = 0; i < 2; ++i) { int R, C; stage_rc(tid * 16 + i * 8192, R, C); voffA[i] = (unsigned)(R * K + C) * 2u; voffB[i] = voffA[i]; RA[i] = R; CA[i] = (unsigned)C * 2u; }
    const size_t kstep = (size_t)(BK * 2);
    const size_t hstep = (size_t)HALF * K * 2;
    const size_t tstep = 2 * hstep;
    const unsigned ldsw = (unsigned)wid * 1024u;
    const int aoff = lds_byte(wr * 64 + fr, fq * 8), boff = lds_byte(wc * 32 + fr, fq * 8);
    unsigned ga[2][2], gn[2][2];
#define PG8_SA(b, h) (((b) * 2 + (h)) * HTB)
#define PG8_SB(b, h) ((4 + (b) * 2 + (h)) * HTB)
#define PG8_STAGE(bufoff, gbase, voff) do { _Pragma("unroll") for (int _i = 0; _i < 2; ++_i) \
        __builtin_amdgcn_global_load_lds((const unsigned*)((const char*)(gbase) + (voff)[_i]), (LAS unsigned*)(lds + (bufoff) + ldsw + _i * 8192), 16, 0, 0); } while (0)
#define PG8_STAGE_A(bufoff, pbase, h, nx) do { if constexpr (GATHER) { \
        const unsigned _o0 = (nx) ? gn[h][0] : ga[h][0], _o1 = (nx) ? gn[h][1] : ga[h][1]; \
        __builtin_amdgcn_global_load_lds((const unsigned*)((const char*)(pbase) + _o0), (LAS unsigned*)(lds + (bufoff) + ldsw), 16, 0, 0); \
        __builtin_amdgcn_global_load_lds((const unsigned*)((const char*)(pbase) + _o1), (LAS unsigned*)(lds + (bufoff) + ldsw + 8192), 16, 0, 0); \
    } else { PG8_STAGE(bufoff, (const char*)(pbase) + ((h) ? hstep : (size_t)0), voffA); } } while (0)
#define PG8_GOFF(dst, pm_) do { if constexpr (GATHER) { _Pragma("unroll") for (int _h = 0; _h < 2; ++_h) _Pragma("unroll") for (int _i = 0; _i < 2; ++_i) \
        dst[_h][_i] = (unsigned)g.rows[(pm_) * BM + _h * HALF + RA[_i]] * (unsigned)(K * 2) + CA[_i]; } } while (0)
#define PG8_LDA(dst, b, h) do { _Pragma("unroll") for (int m = 0; m < 4; ++m) _Pragma("unroll") for (int k = 0; k < 2; ++k) dst[m][k] = *(const LAS bf16x8*)(lds + PG8_SA(b, h) + aoff + m * 2048 + k * 1024); } while (0)
#define PG8_LDB(dst, b, h) do { _Pragma("unroll") for (int n = 0; n < 2; ++n) _Pragma("unroll") for (int k = 0; k < 2; ++k) dst[n][k] = *(const LAS bf16x8*)(lds + PG8_SB(b, h) + boff + n * 2048 + k * 1024); } while (0)
#define PG8_MMA(ai, bj, At, Bt) do { __builtin_amdgcn_s_setprio(1); _Pragma("unroll") for (int m = 0; m < 4; ++m) _Pragma("unroll") for (int n = 0; n < 2; ++n) _Pragma("unroll") for (int k = 0; k < 2; ++k) \
        acc[ai][bj][m][n] = __builtin_amdgcn_mfma_f32_16x16x32_bf16(Bt[n][k], At[m][k], acc[ai][bj][m][n], 0, 0, 0); __builtin_amdgcn_s_setprio(0); } while (0)
#define PG8_WAIT_V(n) asm volatile("s_waitcnt vmcnt(" #n ")" ::: "memory")
#define PG8_WAIT_L(n) asm volatile("s_waitcnt lgkmcnt(" #n ")" ::: "memory")
#define PG8_BAR __builtin_amdgcn_s_barrier()
#define PG8_SCHED __builtin_amdgcn_sched_barrier(0)
    Unit cur, nxt; int ui = 0;
    if (!S.next(0, cur)) return;
    f32x4 acc[2][2][4][2];
#pragma unroll
    for (int a = 0; a < 2; ++a)
#pragma unroll
        for (int b = 0; b < 2; ++b)
#pragma unroll
            for (int m = 0; m < 4; ++m)
#pragma unroll
                for (int n = 0; n < 2; ++n) acc[a][b][m][n] = (f32x4){0.f, 0.f, 0.f, 0.f};
    bf16x8 At[4][2], B0[2][2], B1[2][2];
    const char* cA = GATHER ? (const char*)g.A : (const char*)g.A + (size_t)cur.pm * tstep; const char* cB = (const char*)g.Bt + (size_t)cur.pb * tstep;
    PG8_GOFF(ga, cur.pm);
    PG8_STAGE(PG8_SB(0, 0), cB, voffB); PG8_STAGE(PG8_SB(0, 1), cB + hstep, voffB); PG8_STAGE_A(PG8_SA(0, 0), cA, 0, false); PG8_STAGE_A(PG8_SA(0, 1), cA, 1, false);
    if (wr == 1) PG8_BAR;
    PG8_WAIT_V(2); PG8_BAR;
    PG8_STAGE(PG8_SB(1, 0), cB + kstep, voffB); PG8_STAGE_A(PG8_SA(1, 0), cA + kstep, 0, false); PG8_STAGE(PG8_SB(1, 1), cB + hstep + kstep, voffB);
    PG8_WAIT_V(6); PG8_BAR;
    for (;;) {
        const bool has_next = S.next(ui + 1, nxt);
        const char* nA = has_next ? (GATHER ? (const char*)g.A : (const char*)g.A + (size_t)nxt.pm * tstep) : cA; const char* nB = has_next ? (const char*)g.Bt + (size_t)nxt.pb * tstep : cB;
        if constexpr (GATHER) { if (has_next) { PG8_GOFF(gn, nxt.pm); } else {
#pragma unroll
            for (int _h = 0; _h < 2; ++_h)
#pragma unroll
                for (int _i = 0; _i < 2; ++_i) gn[_h][_i] = ga[_h][_i]; } }
        for (int t = 0; t < nt; t += 2) {
            const bool last = (t == nt - 2);
            const char* a1 = cA + (size_t)(t + 1) * kstep;
            const char* a2 = last ? nA : cA + (size_t)(t + 2) * kstep; const char* b2 = last ? nB : cB + (size_t)(t + 2) * kstep;
            const char* a3 = a2 + kstep; const char* b3 = b2 + kstep;
            PG8_LDB(B0, 0, 0); PG8_LDB(B1, 0, 1); PG8_SCHED; PG8_LDA(At, 0, 0); PG8_STAGE_A(PG8_SA(1, 1), a1, 1, false);
            PG8_WAIT_V(8); PG8_WAIT_L(0); PG8_BAR; PG8_MMA(0, 0, At, B0); PG8_MMA(0, 1, At, B1); PG8_BAR; PG8_SCHED;
            PG8_LDA(At, 0, 1); PG8_STAGE(PG8_SB(0, 0), b2, voffB); PG8_STAGE(PG8_SB(0, 1), b2 + hstep, voffB); PG8_STAGE_A(PG8_SA(0, 0), a2, 0, last);
            PG8_WAIT_V(8); PG8_WAIT_L(0); PG8_BAR; PG8_MMA(1, 0, At, B0); PG8_MMA(1, 1, At, B1); PG8_BAR; PG8_SCHED;
            PG8_LDB(B0, 1, 0); PG8_LDB(B1, 1, 1); PG8_SCHED; PG8_LDA(At, 1, 0); PG8_STAGE_A(PG8_SA(0, 1), a2, 1, last);
            PG8_WAIT_V(8); PG8_WAIT_L(0); PG8_BAR; PG8_MMA(0, 0, At, B0); PG8_MMA(0, 1, At, B1); PG8_BAR; PG8_SCHED;
            PG8_LDA(At, 1, 1); PG8_STAGE(PG8_SB(1, 0), b3, voffB); PG8_STAGE(PG8_SB(1, 1), b3 + hstep, voffB); PG8_STAGE_A(PG8_SA(1, 0), a3, 0, last);
            PG8_WAIT_V(8); PG8_WAIT_L(0); PG8_BAR; PG8_MMA(1, 0, At, B0); PG8_MMA(1, 1, At, B1); PG8_BAR; PG8_SCHED;
        }
        if (wr == 0) PG8_BAR;
        E(acc, cur, wr, wc, fr, fq);
        if (!has_next) break;
#pragma unroll
        for (int a = 0; a < 2; ++a)
#pragma unroll
            for (int b = 0; b < 2; ++b)
#pragma unroll
                for (int m = 0; m < 4; ++m)
#pragma unroll
                    for (int n = 0; n < 2; ++n) acc[a][b][m][n] = (f32x4){0.f, 0.f, 0.f, 0.f};
        cur = nxt; cA = nA; cB = nB; ++ui;
        if constexpr (GATHER) {
#pragma unroll
            for (int _h = 0; _h < 2; ++_h)
#pragma unroll
                for (int _i = 0; _i < 2; ++_i) ga[_h][_i] = gn[_h][_i]; }
        if (wr == 1) PG8_BAR;
    }
    PG8_WAIT_V(0);
    PG8_BAR;
#undef PG8_SA
#undef PG8_SB
#undef PG8_STAGE
#undef PG8_STAGE_A
#undef PG8_GOFF
#undef PG8_LDA
#undef PG8_LDB
#undef PG8_MMA
#undef PG8_WAIT_V
#undef PG8_WAIT_L
#undef PG8_BAR
#undef PG8_SCHED
}

struct EpiF32 {
    float* C; int ldc;
    __device__ __forceinline__ void operator()(const f32x4 (&acc)[2][2][4][2], const Unit& u, int wr, int wc, int fr, int fq) const {
        const int row0 = u.pm * BM + wr * 64 + fr, col0 = u.pn * BM + wc * 32 + 4 * fq;
#pragma unroll
        for (int ai = 0; ai < 2; ++ai)
#pragma unroll
            for (int m = 0; m < 4; ++m) { float* rowp = C + (size_t)(row0 + ai * HALF + m * 16) * ldc + col0;
#pragma unroll
                for (int bj = 0; bj < 2; ++bj)
#pragma unroll
                    for (int n = 0; n < 2; ++n) *(f32x4*)(rowp + bj * HALF + n * 16) = acc[ai][bj][m][n]; }
    }
};
struct EpiSwiGlu {
    bf16_t* G;
    __device__ __forceinline__ void operator()(const f32x4 (&acc)[2][2][4][2], const Unit& u, int wr, int wc, int fr, int fq) const {
        const int row0 = u.pm * BM + wr * 64 + fr, c0 = u.pn * 128 + wc * 16 + 4 * fq;
#pragma unroll
        for (int ai = 0; ai < 2; ++ai)
#pragma unroll
            for (int m = 0; m < 4; ++m) { bf16_t* rowp = G + (size_t)(row0 + ai * HALF + m * 16) * DEXP + c0;
#pragma unroll
                for (int bj = 0; bj < 2; ++bj) { const f32x4 a1 = acc[ai][bj][m][0], a3 = acc[ai][bj][m][1];
                    u32x2 w; w.x = pk2(siluf_(a1[0]) * a3[0], siluf_(a1[1]) * a3[1]); w.y = pk2(siluf_(a1[2]) * a3[2], siluf_(a1[3]) * a3[3]);
                    *(u32x2*)(rowp + bj * 64) = w; } }
    }
};
struct EpiScatter {
    bf16_t* Y; const int* dest;
    __device__ __forceinline__ void operator()(const f32x4 (&acc)[2][2][4][2], const Unit& u, int wr, int wc, int fr, int fq) const {
        const int row0 = u.pm * BM + wr * 64 + fr, col0 = u.pn * BM + wc * 32 + 4 * fq;
#pragma unroll
        for (int ai = 0; ai < 2; ++ai)
#pragma unroll
            for (int m = 0; m < 4; ++m) { const int d = dest[row0 + ai * HALF + m * 16];
                if (d >= 0) { bf16_t* rowp = Y + (size_t)d * DM + col0;
#pragma unroll
                    for (int bj = 0; bj < 2; ++bj)
#pragma unroll
                        for (int n = 0; n < 2; ++n) { const f32x4 v = acc[ai][bj][m][n]; u32x2 w; w.x = pk2(v[0], v[1]); w.y = pk2(v[2], v[3]); *(u32x2*)(rowp + bj * HALF + n * 16) = w; } } }
    }
};

__device__ __forceinline__ void sincos_rev(float rev, float& s, float& c) { rev = rev - floorf(rev); s = __builtin_amdgcn_sinf(rev); c = __builtin_amdgcn_cosf(rev); }
struct EpiInProj {
    unsigned char* wsb;
    template <int BJ> __device__ __forceinline__ void half(const f32x4 (&acc)[2][2][4][2], const Unit& u, int wr, int wc, int fr, int fq) const {
        const int ht = 2 * u.pn + BJ; const int row0 = u.pm * BM + wr * 64 + fr;
        if (ht < 8) {
            const int i0 = 16 * wc + 4 * fq; float invf[4];
#pragma unroll
            for (int e = 0; e < 4; ++e) invf[e] = __builtin_amdgcn_exp2f(-(float)(i0 + e) * (13.287712379549449f / 64.0f)) * 0.15915494309189535f;
            bf16_t* dst = (bf16_t*)(wsb + ((ht < 4) ? WS_RQ : WS_RK)); const float sc = (ht < 4) ? 1.0f : 0.08838834764831845f; const int hh = ht & 3;
#pragma unroll
            for (int ai = 0; ai < 2; ++ai)
#pragma unroll
                for (int m = 0; m < 4; ++m) { const int row = row0 + ai * HALF + m * 16; const float t = (float)(row & (SEQ - 1));
                    const f32x4 v0 = acc[ai][BJ][m][0], v1 = acc[ai][BJ][m][1]; float o1[4], o2[4];
#pragma unroll
                    for (int e = 0; e < 4; ++e) { float sn, cs; sincos_rev(t * invf[e], sn, cs); o1[e] = (v0[e] * cs - v1[e] * sn) * sc; o2[e] = (v1[e] * cs + v0[e] * sn) * sc; }
                    bf16_t* p = dst + (size_t)row * 512 + hh * 128 + i0;
                    u32x2 w; w.x = pk2(o1[0], o1[1]); w.y = pk2(o1[2], o1[3]); *(u32x2*)p = w; w.x = pk2(o2[0], o2[1]); w.y = pk2(o2[2], o2[3]); *(u32x2*)(p + 64) = w; asm volatile("" ::: "memory"); }
        } else if (ht < 24 || (ht >= 35 && ht < 51)) {
            size_t doff; int hb, act;
            if (ht < 16) { doff = WS_RV; hb = ht - 8; act = 0; } else if (ht < 24) { doff = WS_RG; hb = ht - 16; act = 1; } else if (ht < 43) { doff = WS_MR; hb = ht - 35; act = 2; } else { doff = WS_MN; hb = ht - 43; act = 2; }
            bf16_t* dst = (bf16_t*)(wsb + doff);
            const int col0 = hb * 128 + 32 * wc + 4 * fq;
#pragma unroll
            for (int ai = 0; ai < 2; ++ai)
#pragma unroll
                for (int m = 0; m < 4; ++m) { const int row = row0 + ai * HALF + m * 16;
#pragma unroll
                    for (int n = 0; n < 2; ++n) { f32x4 v = acc[ai][BJ][m][n];
                        if (act == 1) { v[0] = siluf_(v[0]); v[1] = siluf_(v[1]); v[2] = siluf_(v[2]); v[3] = siluf_(v[3]); }
                        else if (act == 2) { v[0] = sigmoidf_(v[0]); v[1] = sigmoidf_(v[1]); v[2] = sigmoidf_(v[2]); v[3] = sigmoidf_(v[3]); }
                        u32x2 w; w.x = pk2(v[0], v[1]); w.y = pk2(v[2], v[3]); *(u32x2*)(dst + (size_t)row * 1024 + col0 + 16 * n) = w; } asm volatile("" ::: "memory"); }
        } else if (ht < 28 || ht == 28 || ht == 30 || ht == 32) {
            const int hin = wc >> 1, j0 = 16 * (wc & 1) + 4 * fq; float invf[4];
#pragma unroll
            for (int e = 0; e < 4; ++e) invf[e] = __builtin_amdgcn_exp2f(-(float)(j0 + e) * (13.287712379549449f / 32.0f)) * 0.15915494309189535f;
#pragma unroll
            for (int ai = 0; ai < 2; ++ai)
#pragma unroll
                for (int m = 0; m < 4; ++m) { const int row = row0 + ai * HALF + m * 16; const int tt = row & (SEQ - 1), b = row >> 12; const float t = (float)tt;
                    const f32x4 v0 = acc[ai][BJ][m][0], v1 = acc[ai][BJ][m][1]; float o1[4], o2[4];
#pragma unroll
                    for (int e = 0; e < 4; ++e) { float sn, cs; sincos_rev(t * invf[e], sn, cs); o1[e] = v0[e] * cs - v1[e] * sn; o2[e] = v1[e] * cs + v0[e] * sn; }
                    const size_t eo = (ht < 28) ? WS_NQ / 2 + (size_t)row * 512 + ((ht - 24) * 2 + hin) * 64 + j0
                                                : WS_KV6 / 2 + (size_t)(ht - 28) * KVSZ + ((size_t)(b * 2 + hin) * SEQ + tt) * 64 + j0;
                    bf16_t* p = (bf16_t*)wsb + eo;
                    u32x2 w; w.x = pk2(o1[0], o1[1]); w.y = pk2(o1[2], o1[3]); *(u32x2*)p = w; w.x = pk2(o2[0], o2[1]); w.y = pk2(o2[2], o2[3]); *(u32x2*)(p + 32) = w; asm volatile("" ::: "memory"); }
        } else if (ht == 29 || ht == 31 || ht == 33) {
            const int hin = wc >> 1, d0 = 32 * (wc & 1) + 4 * fq;
#pragma unroll
            for (int ai = 0; ai < 2; ++ai)
#pragma unroll
                for (int m = 0; m < 4; ++m) { const int row = row0 + ai * HALF + m * 16; const int tt = row & (SEQ - 1), b = row >> 12;
                    bf16_t* p = (bf16_t*)(wsb + WS_KV6) + (size_t)(ht - 28) * KVSZ + ((size_t)(b * 2 + hin) * SEQ + tt) * 64 + d0;
#pragma unroll
                    for (int n = 0; n < 2; ++n) { const f32x4 v = acc[ai][BJ][m][n]; u32x2 w; w.x = pk2(v[0], v[1]); w.y = pk2(v[2], v[3]); *(u32x2*)(p + 16 * n) = w; } }
        } else if (ht == 34) {
            if (wc == 0) {
#pragma unroll
                for (int ai = 0; ai < 2; ++ai)
#pragma unroll
                    for (int m = 0; m < 4; ++m) { const int row = row0 + ai * HALF + m * 16;
#pragma unroll
                        for (int n = 0; n < 2; ++n) { if (n == 0 || fq < 2) { const f32x4 v = acc[ai][BJ][m][n];
                            *(f32x4*)((float*)(wsb + WS_NG) + (size_t)row * 32 + 16 * n + 4 * fq) = (f32x4){sigmoidf_(v[0]), sigmoidf_(v[1]), sigmoidf_(v[2]), sigmoidf_(v[3])}; } } }
            }
        }
    }
    __device__ __forceinline__ void operator()(const f32x4 (&acc)[2][2][4][2], const Unit& u, int wr, int wc, int fr, int fq) const {
        half<0>(acc, u, wr, wc, fr, fq); half<1>(acc, u, wr, wc, fr, fq);
    }
};
struct EpiGate {
    bf16_t* O; const bf16_t* gate; const bf16_t* add;
    __device__ __forceinline__ void operator()(const f32x4 (&acc)[2][2][4][2], const Unit& u, int wr, int wc, int fr, int fq) const {
        const int row0 = u.pm * BM + wr * 64 + fr, col0 = u.pn * BM + wc * 32 + 4 * fq;
#pragma unroll
        for (int ai = 0; ai < 2; ++ai)
#pragma unroll
            for (int m = 0; m < 4; ++m) { const size_t off = (size_t)(row0 + ai * HALF + m * 16) * 1024 + col0;
#pragma unroll
                for (int bj = 0; bj < 2; ++bj)
#pragma unroll
                    for (int n = 0; n < 2; ++n) { const size_t o = off + bj * HALF + n * 16; const f32x4 v = acc[ai][bj][m][n]; const u32x2 gt = *(const u32x2*)(gate + o);
                        float r0 = v[0] * bf_lo(gt.x), r1 = v[1] * bf_hi(gt.x), r2 = v[2] * bf_lo(gt.y), r3 = v[3] * bf_hi(gt.y);
                        if (add) { const u32x2 ad = *(const u32x2*)(add + o); r0 += bf_lo(ad.x); r1 += bf_hi(ad.x); r2 += bf_lo(ad.y); r3 += bf_hi(ad.y); }
                        u32x2 w; w.x = pk2(r0, r1); w.y = pk2(r2, r3); *(u32x2*)(O + o) = w; } }
    }
};
struct EpiResid {
    float* O; const float* xin; const float* mod;
    __device__ __forceinline__ void operator()(const f32x4 (&acc)[2][2][4][2], const Unit& u, int wr, int wc, int fr, int fq) const {
        const int row0 = u.pm * BM + wr * 64 + fr, col0 = u.pn * BM + wc * 32 + 4 * fq; const int b = (u.pm * BM) >> 12;
        f32x4 g1[2][2];
#pragma unroll
        for (int bj = 0; bj < 2; ++bj)
#pragma unroll
            for (int n = 0; n < 2; ++n) g1[bj][n] = *(const f32x4*)(mod + b * 6144 + 2048 + col0 + bj * HALF + n * 16) + 1.0f;
#pragma unroll
        for (int ai = 0; ai < 2; ++ai)
#pragma unroll
            for (int m = 0; m < 4; ++m) { const size_t off = (size_t)(row0 + ai * HALF + m * 16) * 1024 + col0;
#pragma unroll
                for (int bj = 0; bj < 2; ++bj)
#pragma unroll
                    for (int n = 0; n < 2; ++n) { const size_t o = off + bj * HALF + n * 16; *(f32x4*)(O + o) = *(const f32x4*)(xin + o) * ALPHA + g1[bj][n] * acc[ai][bj][m][n]; } }
    }
};
}


typedef short v4i16_t __attribute__((ext_vector_type(4)));
__device__ __forceinline__ int crow(int r, int hi) { return (r & 3) + 8 * (r >> 2) + 4 * hi; }
__device__ __forceinline__ unsigned cvtpk(float lo, float hi) { unsigned r; asm volatile("v_cvt_pk_bf16_f32 %0, %1, %2" : "=v"(r) : "v"(lo), "v"(hi)); return r; }
#define KSWZ256(row, colB) ((row) * 256 + ((colB) ^ (((row) & 7) << 4)))
#define KSWZ128(row, colB) ((row) * 128 + ((colB) ^ (((row) & 7) << 4)))
template <int NCB> __device__ __forceinline__ int tr_st(int i, int c) { const int ii = (i & ~0xC) | ((i & 4) << 1) | ((i & 8) >> 1); return ((ii >> 3) * NCB + (c >> 5)) * 512 + ((ii & 7) * 32 + (c & 31)) * 2; }
__device__ __forceinline__ int tr_rd_base(int lane) { return ((lane & 3) << 3) | (((lane >> 2) & 3) << 6) | (((lane >> 4) & 1) << 5) | (((lane >> 5) & 1) << 8); }
template <int NCB> __device__ __forceinline__ bf16x8 tr_frag(LAS const unsigned char* imgb, int cb, int s16) {
    const v4i16_t lo = __builtin_amdgcn_ds_read_tr16_b64_v4i16((LAS v4i16_t*)(imgb + ((2 * s16) * NCB + cb) * 512));
    const v4i16_t hi = __builtin_amdgcn_ds_read_tr16_b64_v4i16((LAS v4i16_t*)(imgb + ((2 * s16 + 1) * NCB + cb) * 512));
    return (bf16x8){lo[0], lo[1], lo[2], lo[3], hi[0], hi[1], hi[2], hi[3]};
}
#define PK4(P, BASE, OUT) do { unsigned a0_ = cvtpk(P[BASE + 0], P[BASE + 1]), a1_ = cvtpk(P[BASE + 2], P[BASE + 3]);   \
    unsigned b0_ = cvtpk(P[BASE + 4], P[BASE + 5]), b1_ = cvtpk(P[BASE + 6], P[BASE + 7]);                              \
    auto r0_ = __builtin_amdgcn_permlane32_swap(a0_, b0_, false, false); auto r1_ = __builtin_amdgcn_permlane32_swap(a1_, b1_, false, false); \
    u32x4 w_ = {r0_[0], r1_[0], r0_[1], r1_[1]}; OUT = __builtin_bit_cast(bf16x8, w_); } while (0)

__device__ __forceinline__ float ret_log2gamma(int h) { return h == 0 ? -0.045803689613f : h == 1 ? -0.022720076500f : h == 2 ? -0.011315313227f : -0.005646563141f; }
__device__ __forceinline__ bf16x8 scale_bf8(bf16x8 v, float f) {
    u32x4 w = __builtin_bit_cast(u32x4, v);
    w.x = pk2(bf_lo(w.x) * f, bf_hi(w.x) * f); w.y = pk2(bf_lo(w.y) * f, bf_hi(w.y) * f); w.z = pk2(bf_lo(w.z) * f, bf_hi(w.z) * f); w.w = pk2(bf_lo(w.w) * f, bf_hi(w.w) * f);
    return __builtin_bit_cast(bf16x8, w);
}
__device__ __forceinline__ void ret_kv_unit(int unit, const bf16_t* RK, const bf16_t* RV, float* KVS, LAS unsigned char* lds) {
    const int tid = opaque_tid(), lane = tid & 63, wave = __builtin_amdgcn_readfirstlane(tid >> 6), r32 = lane & 31, hi = lane >> 5;
    const int b = unit >> 7, n = (unit >> 2) & 31, h = unit & 3; const size_t tok0 = (size_t)b * SEQ + n * 128; const float lg = ret_log2gamma(h);
    LAS unsigned char* Vimg = lds; LAS unsigned char* Kimg = lds + 65536;
#pragma unroll
    for (int j = 0; j < 8; ++j) { const int p = tid + 512 * j, i = p >> 5, c = (p & 31) * 8;
        *(LAS bf16x8*)(Vimg + tr_st<8>(i, c)) = *(const bf16x8*)(RV + (tok0 + i) * 1024 + h * 256 + c); }
#pragma unroll
    for (int j = 0; j < 4; ++j) { const int p = tid + 512 * j, i = p >> 4, c = (p & 15) * 8;
        const bf16x8 kv = *(const bf16x8*)(RK + (tok0 + i) * 512 + h * 128 + c);
        *(LAS bf16x8*)(Kimg + tr_st<4>(i, c)) = scale_bf8(kv, __builtin_amdgcn_exp2f((float)(127 - i) * lg)); }
    __syncthreads();
    f32x16 acc[4];
#pragma unroll
    for (int db = 0; db < 4; ++db) acc[db] = f32x16{};
    const int rb = tr_rd_base(lane);
#pragma unroll
    for (int s16 = 0; s16 < 8; ++s16) {
        const bf16x8 af = tr_frag<8>(Vimg + rb, wave, s16);
#pragma unroll
        for (int db = 0; db < 4; ++db) { const bf16x8 bf = tr_frag<4>(Kimg + rb, db, s16); acc[db] = __builtin_amdgcn_mfma_f32_32x32x16_bf16(af, bf, acc[db], 0, 0, 0); }
    }
    float* dst = KVS + (size_t)unit * 32768;
#pragma unroll
    for (int r = 0; r < 16; ++r) { const int e = 32 * wave + crow(r, hi);
#pragma unroll
        for (int db = 0; db < 4; ++db) dst[e * 128 + 32 * db + r32] = acc[db][r]; }
    __syncthreads();
}
__device__ __forceinline__ void ret_out_unit(int unit, const bf16_t* RQ, const bf16_t* RK, const bf16_t* RV, const bf16_t* RGs, const bf16_t* PREV, bf16_t* YRET, LAS unsigned char* lds) {
    const int tid = opaque_tid(), lane = tid & 63, wave = __builtin_amdgcn_readfirstlane(tid >> 6), r32 = lane & 31, hi = lane >> 5, wr = wave >> 1, wc = wave & 1;
    const int b = unit >> 7, n = (unit >> 2) & 31, h = unit & 3; const size_t tok0 = (size_t)b * SEQ + n * 128; const float lg = ret_log2gamma(h);
    LAS unsigned char* Pimg = lds; LAS unsigned char* Vimg = lds; LAS unsigned char* Kimg = lds + 65536; LAS float* stats = (LAS float*)(lds + 98304);
    const bf16_t* prev = PREV + (size_t)unit * 32768;
#pragma unroll
    for (int j = 0; j < 8; ++j) { const int p = tid + 512 * j, e = p >> 4, cB = (p & 15) * 16; *(LAS bf16x8*)(Pimg + KSWZ256(e, cB)) = *(const bf16x8*)(prev + e * 128 + (cB >> 1)); }
#pragma unroll
    for (int j = 0; j < 4; ++j) { const int p = tid + 512 * j, jj = p >> 4, cB = (p & 15) * 16; *(LAS bf16x8*)(Kimg + KSWZ256(jj, cB)) = *(const bf16x8*)(RK + (tok0 + jj) * 512 + h * 128 + (cB >> 1)); }
    bf16x8 vreg[8];
#pragma unroll
    for (int j = 0; j < 8; ++j) { const int p = tid + 512 * j, i = p >> 5, c = (p & 31) * 8; vreg[j] = *(const bf16x8*)(RV + (tok0 + i) * 1024 + h * 256 + c); }
    bf16x8 qr[8];
#pragma unroll
    for (int d0 = 0; d0 < 8; ++d0) qr[d0] = *(const bf16x8*)(RQ + (tok0 + 32 * wr + r32) * 512 + h * 128 + 16 * d0 + 8 * hi);
    __syncthreads();
    f32x16 o[4];
#pragma unroll
    for (int cb = 0; cb < 4; ++cb) { o[cb] = f32x16{};
#pragma unroll
        for (int d0 = 0; d0 < 8; ++d0) { const bf16x8 bf = *(const LAS bf16x8*)(Pimg + KSWZ256(128 * wc + 32 * cb + r32, (16 * d0 + 8 * hi) * 2));
            o[cb] = __builtin_amdgcn_mfma_f32_32x32x16_bf16(qr[d0], bf, o[cb], 0, 0, 0); } }
#pragma unroll
    for (int r = 0; r < 16; ++r) { const float xi = __builtin_amdgcn_exp2f((float)(32 * wr + crow(r, hi) + 1) * lg);
#pragma unroll
        for (int cb = 0; cb < 4; ++cb) o[cb][r] *= xi; }
    __syncthreads();
#pragma unroll
    for (int j = 0; j < 8; ++j) { const int p = tid + 512 * j, i = p >> 5, c = (p & 31) * 8; *(LAS bf16x8*)(Vimg + tr_st<8>(i, c)) = vreg[j]; }
    __syncthreads();
    const int rb = tr_rd_base(lane);
#pragma unroll 1
    for (int jb = 0; jb <= wr; ++jb) {
        f32x16 p = f32x16{};
#pragma unroll
        for (int d0 = 0; d0 < 8; ++d0) { const bf16x8 af = *(const LAS bf16x8*)(Kimg + KSWZ256(32 * jb + r32, (16 * d0 + 8 * hi) * 2));
            p = __builtin_amdgcn_mfma_f32_32x32x16_bf16(af, qr[d0], p, 0, 0, 0); }
        const int iq = 32 * wr + r32;
#pragma unroll
        for (int r = 0; r < 16; ++r) { const int diff = iq - (32 * jb + crow(r, hi)); p[r] = diff >= 0 ? p[r] * __builtin_amdgcn_exp2f((float)diff * lg) : 0.f; }
        bf16x8 pa0, pa1; PK4(p, 0, pa0); PK4(p, 8, pa1);
#pragma unroll
        for (int cb = 0; cb < 4; ++cb) {
            const bf16x8 v0 = tr_frag<8>(Vimg + rb, 4 * wc + cb, 2 * jb), v1 = tr_frag<8>(Vimg + rb, 4 * wc + cb, 2 * jb + 1);
            o[cb] = __builtin_amdgcn_mfma_f32_32x32x16_bf16(pa0, v0, o[cb], 0, 0, 0);
            o[cb] = __builtin_amdgcn_mfma_f32_32x32x16_bf16(pa1, v1, o[cb], 0, 0, 0); }
    }
#pragma unroll
    for (int r = 0; r < 16; ++r) { float sm = (o[0][r] + o[1][r]) + (o[2][r] + o[3][r]); float sq = (o[0][r] * o[0][r] + o[1][r] * o[1][r]) + (o[2][r] * o[2][r] + o[3][r] * o[3][r]);
#pragma unroll
        for (int x = 1; x < 32; x <<= 1) { sm += __shfl_xor(sm, x); sq += __shfl_xor(sq, x); }
        if (r32 == 0) { stats[((wr * 2 + wc) * 32 + crow(r, hi)) * 2] = sm; stats[((wr * 2 + wc) * 32 + crow(r, hi)) * 2 + 1] = sq; } }
    __syncthreads();
#pragma unroll
    for (int r = 0; r < 16; ++r) { const int row = crow(r, hi);
        const float sm = stats[((wr * 2) * 32 + row) * 2] + stats[((wr * 2 + 1) * 32 + row) * 2], sq = stats[((wr * 2) * 32 + row) * 2 + 1] + stats[((wr * 2 + 1) * 32 + row) * 2 + 1];
        const float mean = sm * (1.f / 256.f), var = fmaxf(sq * (1.f / 256.f) - mean * mean, 0.f), rstd = 1.f / sqrtf(var + LN_EPS);
        const size_t off = (tok0 + 32 * wr + row) * 1024 + h * 256 + 128 * wc + r32;
#pragma unroll
        for (int cb = 0; cb < 4; ++cb) { const float gsl = __builtin_bit_cast(float, (unsigned)RGs[off + 32 * cb] << 16);
            YRET[off + 32 * cb] = (bf16_t)f2bf((o[cb][r] - mean) * rstd * gsl); }
        if (r & 1) asm volatile("" ::: "memory"); }
    __syncthreads();
}

__device__ __forceinline__ void nsa_cmp_unit(int unit, const bf16_t* KV6p, const bf16_t* WCKp, const float* CBIASp, bf16_t* KCMPp, LAS unsigned char* lds) {
    const int tid = opaque_tid(), lane = tid & 63, wave = __builtin_amdgcn_readfirstlane(tid >> 6), r32 = lane & 31, hi = lane >> 5;
    const int which = unit >> 7, rb = unit & 127;
    const bf16_t* arr = KV6p + (size_t)which * KVSZ; const bf16_t* Wt = WCKp + (size_t)which * (64 * 2048);
    f32x16 acc[2]; acc[0] = f32x16{}; acc[1] = f32x16{};
    const bf16_t* ap = arr + (size_t)(rb * 32 + r32) * 1024 + wave * 256 + 8 * hi;
    const bf16_t* bp = Wt + (size_t)r32 * 2048 + wave * 256 + 8 * hi;
#pragma unroll 4
    for (int ks = 0; ks < 16; ++ks) {
        const bf16x8 af = *(const bf16x8*)(ap + 16 * ks), b0 = *(const bf16x8*)(bp + 16 * ks), b1 = *(const bf16x8*)(bp + 32 * 2048 + 16 * ks);
        acc[0] = __builtin_amdgcn_mfma_f32_32x32x16_bf16(af, b0, acc[0], 0, 0, 0);
        acc[1] = __builtin_amdgcn_mfma_f32_32x32x16_bf16(af, b1, acc[1], 0, 0, 0);
    }
    LAS float* red = (LAS float*)lds;
#pragma unroll
    for (int r = 0; r < 16; ++r) { red[(wave * 32 + crow(r, hi)) * 64 + r32] = acc[0][r]; red[(wave * 32 + crow(r, hi)) * 64 + 32 + r32] = acc[1][r]; }
    __syncthreads();
#pragma unroll
    for (int q = 0; q < 4; ++q) { const int idx = tid + 512 * q, row = idx >> 6, e = idx & 63; float sacc = CBIASp[which * 64 + e];
#pragma unroll
        for (int w = 0; w < 8; ++w) sacc += red[(w * 32 + row) * 64 + e];
        KCMPp[(size_t)which * (4096 * 64) + (size_t)(rb * 32 + row) * 64 + e] = (bf16_t)f2bf(sacc); }
    __syncthreads();
}

constexpr float NSA_C = 0.125f * 1.4426950408889634f;
template <int GRP>
__device__ __forceinline__ void nsa_tile(const int MODE, f32x16 (&o)[2], float& m_reg, float& l_reg, LAS const unsigned char* Kt, LAS const unsigned char* Vtrb, const bf16x8 (&qr)[4],
                                         LAS float* al_l, int r32, int hi, int qb, int tl, int j, bool selrow) {
    asm volatile("" : "+v"(r32), "+v"(hi));
    f32x16 p0 = f32x16{}, p1 = f32x16{};
#pragma unroll
    for (int d0 = 0; d0 < 4; ++d0) { const int cb = (d0 * 16 + hi * 8) * 2;
        const bf16x8 b0 = *(const LAS bf16x8*)(Kt + KSWZ128(r32, cb)), b1 = *(const LAS bf16x8*)(Kt + KSWZ128(32 + r32, cb));
        p0 = __builtin_amdgcn_mfma_f32_32x32x16_bf16(b0, qr[d0], p0, 0, 0, 0); p1 = __builtin_amdgcn_mfma_f32_32x32x16_bf16(b1, qr[d0], p1, 0, 0, 0); }
    __builtin_amdgcn_sched_barrier(0);
    const float NEG = -INFINITY;
#define KC(r) (((r) & 3) + 8 * ((r) >> 2))
    if (GRP == 0) { int lim = 64 * qb + tl - 31 - 1024 * j - 64 * hi;
        asm volatile("" : "+v"(lim));
#pragma unroll
        for (int r = 0; r < 16; ++r) { if (16 * KC(r) > lim) p0[r] = NEG; if (16 * KC(r) + 512 > lim) p1[r] = NEG; }
    } else if (MODE == 1) {
        int t2 = selrow ? ((j == qb) ? tl - 4 * hi : 1000) : -1000;
        asm volatile("" : "+v"(t2));
#pragma unroll
        for (int r = 0; r < 16; ++r) { if (KC(r) > t2) p0[r] = NEG; if (KC(r) + 32 > t2) p1[r] = NEG; }
    } else {
        if (j == qb) { int t2 = tl - 4 * hi; asm volatile("" : "+v"(t2));
#pragma unroll
            for (int r = 0; r < 16; ++r) { if (KC(r) > t2) p0[r] = NEG; if (KC(r) + 32 > t2) p1[r] = NEG; }
        } else if (j == qb - 8) { int t2 = tl - 4 * hi; asm volatile("" : "+v"(t2));
#pragma unroll
            for (int r = 0; r < 16; ++r) { if (KC(r) <= t2) p0[r] = NEG; if (KC(r) + 32 <= t2) p1[r] = NEG; }
        }
    }
#undef KC
    bf16x8 pa[4];
    if (GRP == 0 && MODE == 3) {
        const float mnC = -m_reg * NSA_C;
#pragma unroll
        for (int r = 0; r < 16; ++r) { p0[r] = __builtin_amdgcn_exp2f(fmaf(p0[r], NSA_C, mnC)); p1[r] = __builtin_amdgcn_exp2f(fmaf(p1[r], NSA_C, mnC)); }
    } else {
        float pmax = p0[0];
#pragma unroll
        for (int r = 1; r < 16; ++r) pmax = fmaxf(pmax, p0[r]);
#pragma unroll
        for (int r = 0; r < 16; ++r) pmax = fmaxf(pmax, p1[r]);
        { auto rr = __builtin_amdgcn_permlane32_swap(__float_as_uint(pmax), __float_as_uint(pmax), false, false); pmax = fmaxf(__uint_as_float(rr[0]), __uint_as_float(rr[1])); }
        const float mn = fmaxf(m_reg, pmax); const float alpha = __builtin_amdgcn_exp2f((m_reg - mn) * NSA_C); m_reg = mn;
        const float mnC = -mn * NSA_C;
        float ps = 0.f;
#pragma unroll
        for (int r = 0; r < 16; ++r) { p0[r] = __builtin_amdgcn_exp2f(fmaf(p0[r], NSA_C, mnC)); p1[r] = __builtin_amdgcn_exp2f(fmaf(p1[r], NSA_C, mnC)); ps += p0[r] + p1[r]; }
        { auto rr = __builtin_amdgcn_permlane32_swap(__float_as_uint(ps), __float_as_uint(ps), false, false); ps = __uint_as_float(rr[0]) + __uint_as_float(rr[1]); }
        l_reg = l_reg * alpha + ps;
        if (__any(alpha < 1.f)) { if (hi == 0) al_l[r32] = alpha; asm volatile("s_waitcnt lgkmcnt(0)" ::: "memory");
#pragma unroll
            for (int r = 0; r < 16; ++r) { const float al = al_l[crow(r, hi)]; o[0][r] *= al; o[1][r] *= al; } }
    }
    PK4(p0, 0, pa[0]); PK4(p0, 8, pa[1]); PK4(p1, 0, pa[2]); PK4(p1, 8, pa[3]);
    __builtin_amdgcn_sched_barrier(0);
    if (GRP == 1 || MODE != 3) {
#pragma unroll
        for (int d0 = 0; d0 < 2; ++d0)
#pragma unroll
            for (int ks = 0; ks < 4; ++ks) { const bf16x8 vf = tr_frag<2>(Vtrb, d0, ks); o[d0] = __builtin_amdgcn_mfma_f32_32x32x16_bf16(pa[ks], vf, o[d0], 0, 0, 0); }
    } else {
#pragma unroll
        for (int d0 = 0; d0 < 2; ++d0) { int nb = 64 * j + 8 * hi + 1 - 4 * (32 * d0 + r32); asm volatile("" : "+v"(nb));
#pragma unroll
            for (int ks = 0; ks < 4; ++ks) { bf16x8 of;
#pragma unroll
                for (int e = 0; e < 8; ++e) of[e] = ((unsigned)(nb + 16 * ks + e) <= 4u) ? (short)0x3F80 : (short)0;
                o[d0] = __builtin_amdgcn_mfma_f32_32x32x16_bf16(pa[ks], of, o[d0], 0, 0, 0); __builtin_amdgcn_sched_barrier(0); } }
    }
}

constexpr int NL_K = 0, NL_V = 16384, NL_IMP = 32768, NL_SEL = 49152, NL_UNI = 49152 + 512, NL_LIST = 49152 + 768, NL_WS = 51200;
#define NSA_LOAD(ksrc, vsrc) do { kreg = *(const bf16x8*)((ksrc) + tid * 8); vreg = *(const bf16x8*)((vsrc) + tid * 8); } while (0)
#define NSA_WRITE(buf) do { *(LAS bf16x8*)(lds + NL_K + (buf) * 8192 + KSWZ128(tid >> 3, (tid & 7) * 16)) = kreg; \
                            *(LAS bf16x8*)(lds + NL_V + (buf) * 8192 + tr_st<2>(tid >> 3, (tid & 7) * 8)) = vreg; } while (0)
__device__ __forceinline__ void nsa_final(const bool SET, f32x16 (&outa)[2], const f32x16& o0, const f32x16& o1, float (&invl)[16], float l_reg, LAS float* l_l, LAS const float* gsc, int br, int r32, int hi) {
    asm volatile("" : "+v"(gsc), "+v"(l_l));
    if (hi == 0) l_l[r32] = l_reg;
    asm volatile("s_waitcnt lgkmcnt(0)" ::: "memory");
#pragma unroll
    for (int r = 0; r < 16; ++r) { const float rl = l_l[crow(r, hi)]; invl[r] = rl > 0.f ? __builtin_amdgcn_rcpf(rl) : 0.f; }
    asm volatile("" ::: "memory");
#pragma unroll
    for (int r = 0; r < 16; ++r) { const float f = invl[r] * gsc[crow(r, hi) * 3 + br];
        if (SET) { outa[0][r] = o0[r] * f; outa[1][r] = o1[r] * f; } else { outa[0][r] += o0[r] * f; outa[1][r] += o1[r] * f; }
        if ((r & 3) == 3) asm volatile("" ::: "memory"); }
}
__device__ __forceinline__ void nsa_attn_unit(int unit, const bf16_t* NQp, const bf16_t* KV6p, const bf16_t* KCMPp, const float* NGp, bf16_t* YNSAp, LAS unsigned char* lds) {
    const int tid = opaque_tid(), lane = tid & 63, wave = __builtin_amdgcn_readfirstlane(tid >> 6), r32 = lane & 31, hi = lane >> 5;
    const int b = unit >> 7, qb = (unit >> 1) & 63, g = unit & 1;
    const int tl = 8 * wave + (r32 & 7), hh = r32 >> 3;
    const size_t tok = (size_t)b * SEQ + 64 * qb + tl;
    LAS float* wsf = (LAS float*)(lds + NL_WS + wave * 1024); LAS float* l_l = wsf; LAS float* al_l = wsf + 32; LAS float* gsc = wsf + 64;
    LAS float* impl = (LAS float*)(lds + NL_IMP); LAS unsigned* selm = (LAS unsigned*)(lds + NL_SEL); LAS int* slist = (LAS int*)(lds + NL_LIST);
    bf16x8 qr[4];
#pragma unroll
    for (int d0 = 0; d0 < 4; ++d0) qr[d0] = *(const bf16x8*)(NQp + tok * 512 + (4 * g + hh) * 64 + 16 * d0 + 8 * hi);
    if (hi == 0) { const float* gp = NGp + tok * 32 + (4 * g + hh) * 3; gsc[r32 * 3 + 0] = gp[0]; gsc[r32 * 3 + 1] = gp[1]; gsc[r32 * 3 + 2] = gp[2]; }
    const int rbv = tr_rd_base(lane);
    const size_t bg = (size_t)(b * 2 + g);
    bf16x8 kreg, vreg;
    f32x16 outa[2];
    {
        const bf16_t* Kc = KCMPp + bg * 256 * 64; const bf16_t* Vc = KCMPp + (size_t)(4096 * 64) + bg * 256 * 64;
        int nct = (4 * qb + 3 + 63) >> 6; if (nct > 4) nct = 4;
        f32x16 o2[2]; o2[0] = f32x16{}; o2[1] = f32x16{};
        float m_reg = -1.0e30f, l_reg = 0.f;
        NSA_LOAD(Kc, Vc); NSA_WRITE(0); __syncthreads();
#pragma unroll 1
        for (int i = 0; i < 2 * nct; ++i) {
            const int c = i < nct ? i : i - nct, i1 = i + 1, c1 = i1 < nct ? i1 : i1 - nct;
            if (i1 < 2 * nct) NSA_LOAD(Kc + c1 * 4096, Vc + c1 * 4096);
            if (i == nct) { float invl[16]; nsa_final(true, outa, o2[0], o2[1], invl, l_reg, l_l, gsc, 0, r32, hi); o2[0] = f32x16{}; o2[1] = f32x16{}; }
            nsa_tile<0>(i < nct ? 0 : 3, o2, m_reg, l_reg, lds + NL_K + (i & 1) * 8192, lds + NL_V + (i & 1) * 8192 + rbv, qr, al_l, r32, hi, qb, tl, c, true);
            if (i1 < 2 * nct) NSA_WRITE(i1 & 1);
            __syncthreads();
        }
        { LAS float* lp = l_l; asm volatile("" : "+v"(lp));
#pragma unroll
          for (int q = 0; q < 4; ++q) { float i0 = 0.f, i1 = 0.f;
#pragma unroll
            for (int h4 = 0; h4 < 4; ++h4) { const float rl = lp[crow(4 * h4 + q, hi)]; const float inv = rl > 0.f ? __builtin_amdgcn_rcpf(rl) : 0.f; i0 += o2[0][4 * h4 + q] * inv; i1 += o2[1][4 * h4 + q] * inv; }
            impl[(8 * wave + q + 4 * hi) * 64 + r32] = i0; impl[(8 * wave + q + 4 * hi) * 64 + 32 + r32] = i1; } }
    }
    __syncthreads();
    {
        const int tk = tid >> 3, jj = tid & 7; unsigned bits = 0u;
        float ev[8];
#pragma unroll
        for (int q = 0; q < 8; ++q) { const int j = jj * 8 + q; float v = impl[tk * 64 + j]; if (j == 0 || j == qb || j == qb - 1) v = 1.0e4f; if (j > qb) v = -1.0e4f; ev[q] = v; }
        int rank[8];
#pragma unroll
        for (int q = 0; q < 8; ++q) rank[q] = 0;
#pragma unroll 4
        for (int i = 0; i < 64; ++i) { float v = impl[tk * 64 + i]; if (i == 0 || i == qb || i == qb - 1) v = 1.0e4f; if (i > qb) v = -1.0e4f;
#pragma unroll
            for (int q = 0; q < 8; ++q) { const int j = jj * 8 + q; rank[q] += (v > ev[q] || (v == ev[q] && i < j)) ? 1 : 0; } }
#pragma unroll
        for (int q = 0; q < 8; ++q) bits |= (rank[q] < 16) ? (1u << q) : 0u;
        unsigned lo = (jj < 4) ? (bits << (8 * jj)) : 0u, hi32 = (jj >= 4) ? (bits << (8 * (jj - 4))) : 0u;
#pragma unroll
        for (int x = 1; x < 8; x <<= 1) { lo |= __shfl_xor(lo, x); hi32 |= __shfl_xor(hi32, x); }
        if (jj == 0) { selm[tk * 2] = lo; selm[tk * 2 + 1] = hi32; }
    }
    __syncthreads();
    if (wave == 0) { unsigned lo = selm[lane * 2], hi32 = selm[lane * 2 + 1];
#pragma unroll
        for (int x = 1; x < 64; x <<= 1) { lo |= __shfl_xor(lo, x); hi32 |= __shfl_xor(hi32, x); }
        if (lane == 0) { int cnt = 0; for (int j = 0; j <= qb; ++j) { const unsigned bit = (j < 32) ? (lo >> j) & 1u : (hi32 >> (j - 32)) & 1u; if (bit) slist[1 + cnt++] = j; } slist[0] = cnt; } }
    __syncthreads();
    const unsigned my_lo = selm[tl * 2], my_hi = selm[tl * 2 + 1];
    {
        const bf16_t* Ks = KV6p + 2 * KVSZ + bg * SEQ * 64; const bf16_t* Vs = KV6p + 3 * KVSZ + bg * SEQ * 64;
        const size_t wofs = 2 * KVSZ;
        const int ns = slist[0], j0 = qb >= 8 ? qb - 8 : 0, nw = qb - j0 + 1, ntot = ns + nw;
        f32x16 o2[2]; o2[0] = f32x16{}; o2[1] = f32x16{};
        float m_reg = -1.0e30f, l_reg = 0.f;
        int jn = slist[1];
        NSA_LOAD(Ks + (size_t)jn * 4096, Vs + (size_t)jn * 4096); NSA_WRITE(0); __syncthreads();
#pragma unroll 1
        for (int i = 0; i < ntot; ++i) {
            const int j = jn, i1 = i + 1;
            if (i1 < ntot) { const bool w1 = i1 >= ns; jn = w1 ? j0 + (i1 - ns) : slist[1 + i1]; const size_t so = (size_t)jn * 4096 + (w1 ? wofs : (size_t)0); NSA_LOAD(Ks + so, Vs + so); }
            if (i == ns) { float invl[16]; nsa_final(false, outa, o2[0], o2[1], invl, l_reg, l_l, gsc, 1, r32, hi); o2[0] = f32x16{}; o2[1] = f32x16{}; m_reg = -1.0e30f; l_reg = 0.f; }
            const bool selrow = ((j < 32) ? (my_lo >> j) : (my_hi >> (j - 32))) & 1u;
            nsa_tile<1>(i < ns ? 1 : 2, o2, m_reg, l_reg, lds + NL_K + (i & 1) * 8192, lds + NL_V + (i & 1) * 8192 + rbv, qr, al_l, r32, hi, qb, tl, j, selrow);
            if (i1 < ntot) NSA_WRITE(i1 & 1);
            __syncthreads();
        }
        float invl[16]; nsa_final(false, outa, o2[0], o2[1], invl, l_reg, l_l, gsc, 2, r32, hi);
    }
#pragma unroll
    for (int r = 0; r < 16; ++r) { const size_t t2 = (size_t)b * SEQ + 64 * qb + 8 * wave + (r & 3) + 4 * hi; bf16_t* p = YNSAp + t2 * 512 + (4 * g + (r >> 2)) * 64 + r32;
        p[0] = (bf16_t)f2bf(outa[0][r]); p[32] = (bf16_t)f2bf(outa[1][r]); }
    __syncthreads();
}

#define XB_TMO      128
#define XB_XCNT(j)  (256  + 64 * (j))
#define XB_XSUB(j)  (1280 + 64 * (j))
#define XB_XGEN(j)  (2304 + 64 * (j))
#define XB_TOP      3328
#define XB_TOPGEN   3392
#define XCD_BAR_WORDS 3456
#define XB_SPIN_CAP (1u << 18)
__device__ __forceinline__ unsigned xb_ld(unsigned* p)              { return __hip_atomic_load(p, __ATOMIC_RELAXED, __HIP_MEMORY_SCOPE_AGENT); }
__device__ __forceinline__ unsigned xb_add(unsigned* p, unsigned v) { return __hip_atomic_fetch_add(p, v, __ATOMIC_RELAXED, __HIP_MEMORY_SCOPE_AGENT); }
__device__ __forceinline__ unsigned xb_xcc_id() { return (unsigned)__builtin_amdgcn_s_getreg((3 << 11) | 20) & 0xFu; }
#define XB_SPIN(cond, bar) do { unsigned _sp = 0; while (cond) { __builtin_amdgcn_s_sleep(1); \
    if ((++_sp & 255u) == 0u) { if (xb_ld(&(bar)[XB_TMO])) break; if (_sp > XB_SPIN_CAP) { atomicAdd(&(bar)[XB_TMO], 1u); break; } } } } while (0)
struct XcdBarrier { unsigned* bar; unsigned x; volatile LAS unsigned* st; };
__device__ __forceinline__ XcdBarrier xcd_barrier_post(unsigned* bar, volatile LAS unsigned* st) {
    XcdBarrier b; b.bar = bar; b.x = xb_xcc_id(); b.st = st;
    if (threadIdx.x == 0) (void)xb_add(&bar[XB_XCNT(b.x)], 1u);
    return b;
}
__device__ __forceinline__ void xcd_barrier_complete(unsigned* bar, unsigned x, unsigned& nloc, unsigned& nx) {
    const unsigned G = gridDim.x * gridDim.y * gridDim.z;
    unsigned sum, cnt, mine, sp = 0u;
    for (;;) {
        sum = 0u; cnt = 0u; mine = 0u;
#pragma unroll
        for (unsigned j = 0; j < 16; ++j) { const unsigned c = xb_ld(&bar[XB_XCNT(j)]); sum += c; cnt += (c > 0u) ? 1u : 0u; mine = (j == x) ? c : mine; }
        if (sum == G) break;
        __builtin_amdgcn_s_sleep(1);
        if ((++sp & 255u) == 0u) { if (xb_ld(&bar[XB_TMO])) break; if (sp > XB_SPIN_CAP) { atomicAdd(&bar[XB_TMO], 1u); break; } }
    }
    nloc = mine > 0u ? mine : 1u; nx = cnt > 0u ? cnt : 1u;
}
__device__ __forceinline__ void xcd_barrier(const XcdBarrier& b) {
    asm volatile("s_waitcnt vmcnt(0)" ::: "memory");
    __syncthreads();
    if (threadIdx.x == 0) {
        unsigned* bar = b.bar;
        __builtin_amdgcn_s_waitcnt(0);
        unsigned nloc = b.st[0], nx = b.st[1];
        if (nloc == 0u) { xcd_barrier_complete(bar, b.x, nloc, nx); b.st[0] = nloc; b.st[1] = nx; }
        const unsigned old = xb_add(&bar[XB_XSUB(b.x)], 1u);
        const unsigned gen = old / nloc;
        if (old + 1u == (gen + 1u) * nloc) {
            __builtin_amdgcn_fence(__ATOMIC_RELEASE, "agent");
            asm volatile("s_waitcnt vmcnt(0)" ::: "memory");
            const unsigned og = xb_add(&bar[XB_TOP], 1u);
            const unsigned tg = og / nx;
            if (og + 1u == (tg + 1u) * nx) xb_add(&bar[XB_TOPGEN], 1u);
            else XB_SPIN(xb_ld(&bar[XB_TOPGEN]) == tg, bar);
            __builtin_amdgcn_fence(__ATOMIC_ACQUIRE, "agent");
            xb_add(&bar[XB_XGEN(b.x)], 1u);
            asm volatile("s_waitcnt vmcnt(0)" ::: "memory");
        } else {
            XB_SPIN(xb_ld(&bar[XB_XGEN(b.x)]) == gen, bar);
            __builtin_amdgcn_fence(__ATOMIC_ACQUIRE, "agent");
            asm volatile("s_waitcnt vmcnt(0)" ::: "memory");
        }
    }
    __syncthreads();
}

#ifndef PROBE
#define PROBE 0
#endif
constexpr int LDS_BYTES = 147456;
constexpr int LDS_MISC = 131072;

struct Args {
    const float* in[24]; float* out; unsigned char* ws;
};

template <class RowFn>
__device__ __forceinline__ void transpose_item(const float* W, int K, int N, bf16_t* WT, int ldk, RowFn dst_row, LAS float* scr, int item, int lane) {
    const int nblk = (N + 31) / 32, kb = item / nblk, nb = item % nblk, k0 = 64 * kb, n0 = 32 * nb;
    const int ncol = n0 + (lane & 31);
#pragma unroll 8
    for (int i = 0; i < 32; ++i) { const int kk = 2 * i + (lane >> 5); scr[kk * 33 + (lane & 31)] = (ncol < N) ? W[(size_t)(k0 + kk) * N + ncol] : 0.f; }
    asm volatile("s_waitcnt lgkmcnt(0)" ::: "memory");
    const int c = lane & 7;
#pragma unroll
    for (int j = 0; j < 4; ++j) { const int n = (lane >> 3) + 8 * j; const LAS float* s = scr + (8 * c) * 33 + n;
        u32x4 o; o.x = pk2(s[0 * 33], s[1 * 33]); o.y = pk2(s[2 * 33], s[3 * 33]); o.z = pk2(s[4 * 33], s[5 * 33]); o.w = pk2(s[6 * 33], s[7 * 33]);
        if (n0 + n < N) *(u32x4*)(WT + (size_t)dst_row(n0 + n) * ldk + k0 + 8 * c) = o; }
    asm volatile("s_waitcnt lgkmcnt(0)" ::: "memory");
}
struct RowInProj { __device__ __forceinline__ int operator()(int c) const {
    int ht, p;
    if (c < 1024) { const int i = c & 127; ht = c >> 7; p = 32 * ((i >> 4) & 3) + 16 * (i >> 6) + 4 * ((i >> 2) & 3) + (i & 3); }
    else if (c < 3072) { ht = c >> 7; p = c & 127; }
    else if (c < 4352) { const int cc = c - 3072; ht = 24 + (cc >> 7); const int q = cc & 127;
        if (ht < 28 || ht == 28 || ht == 30 || ht == 32) { const int hin = q >> 6, i = q & 63, jj = i & 31; p = 32 * (2 * hin + (jj >> 4)) + 16 * (i >> 5) + 4 * ((jj >> 2) & 3) + (jj & 3); }
        else p = q; }
    else if (c < 4376) { ht = 34; p = c - 4352; }
    else { const int cc = c - 4376; ht = 35 + (cc >> 7); p = cc & 127; }
    return ht * 128 + p; } };
struct RowId { int off; __device__ __forceinline__ int operator()(int n) const { return off + n; } };
struct RowE13 { int ex, which; __device__ __forceinline__ int operator()(int c) const {
    const int pn = c >> 7, cc = c & 127, bj = cc >> 6, wc = (cc >> 4) & 3, fq = (cc >> 2) & 3, e = cc & 3;
    return ex * 512 + 256 * pn + 128 * bj + 32 * wc + 16 * which + 4 * fq + e; } };

__global__ void __launch_bounds__(NTHREADS, 2) mega_fwd(Args a) {
    extern __shared__ __attribute__((aligned(16))) unsigned char lds_raw[];
    LAS unsigned char* lds = (LAS unsigned char*)lds_raw;
    cg::grid_group grid = cg::this_grid();
    const int G = gridDim.x, blk = blockIdx.x, NGW = G * NWAVES;
    { volatile LAS unsigned* misc0 = (volatile LAS unsigned*)(lds + LDS_MISC); if (threadIdx.x < 2) misc0[threadIdx.x] = 0u; }
    __syncthreads();
    const XcdBarrier xbar = xcd_barrier_post((unsigned*)(a.ws + WS_CTL) + 4096, (volatile LAS unsigned*)(lds + LDS_MISC));
#define PHASE_IDS const int tid = opaque_tid(), lane = tid & 63, wave = __builtin_amdgcn_readfirstlane(tid >> 6), gw = blk * NWAVES + wave; (void)lane; (void)gw
#define ws (a.ws)
#define X_IN (a.in[0])
#define cvec (a.in[1])
#define w_ada (a.in[2])
#define b_ada (a.in[3])
#define w_in (a.in[4])
#define cmp_pos_k (a.in[5])
#define cmp_pos_v (a.in[6])
#define w_cmp_k (a.in[7])
#define w_cmp_v (a.in[8])
#define w_ret_out (a.in[9])
#define w_nsa_out (a.in[10])
#define w_out (a.in[11])
#define ln1_g (a.in[12])
#define ln1_b (a.in[13])
#define w_router (a.in[14])
#define b_router (a.in[15])
#define w_e1 (a.in[16])
#define w_e3 (a.in[17])
#define w_e2 (a.in[18])
#define w_s1 (a.in[19])
#define w_s3 (a.in[20])
#define w_s2 (a.in[21])
#define ln2_g (a.in[22])
#define ln2_b (a.in[23])
#define OUT_P (a.out)
#define ctl ((unsigned*)(ws + WS_CTL))
#define MOD ((float*)(ws + WS_MOD))
#define WRT ((bf16_t*)(ws + WS_WRT))
#define E13 ((bf16_t*)(ws + WS_E13))
#define E2 ((bf16_t*)(ws + WS_E2))
#define Hb ((bf16_t*)(ws + WS_H))
#define LOGITS ((float*)(ws + WS_LOGITS))
#define EIDX ((int*)(ws + WS_EIDX))
#define WSEL ((float*)(ws + WS_WSEL))
#define LRANK ((int*)(ws + WS_LRANK))
#define BBASE ((int*)(ws + WS_BBASE))
#define ROWTOK ((int*)(ws + WS_ROWTOK))
#define DEST ((int*)(ws + WS_DEST))
#define TILEE ((int*)(ws + WS_TILEE))
#define Gb ((bf16_t*)(ws + WS_G))
#define Yb ((bf16_t*)(ws + WS_Y))
#define WIN ((bf16_t*)(ws + WS_WIN))
#define WRET ((bf16_t*)(ws + WS_WRET))
#define WNSA ((bf16_t*)(ws + WS_WNSA))
#define WOUT ((bf16_t*)(ws + WS_WOUT))
#define WCK ((bf16_t*)(ws + WS_WCK))
#define WCV ((bf16_t*)(ws + WS_WCV))
#define KCMP ((bf16_t*)(ws + WS_KCMP))
#define CBIAS ((float*)(ws + WS_CBIAS))
#define Ub ((bf16_t*)(ws + WS_U))
#define RQ ((bf16_t*)(ws + WS_RQ))
#define RK ((bf16_t*)(ws + WS_RK))
#define RV ((bf16_t*)(ws + WS_RV))
#define RG ((bf16_t*)(ws + WS_RG))
#define NQ ((bf16_t*)(ws + WS_NQ))
#define KV6 ((bf16_t*)(ws + WS_KV6))
#define NG ((float*)(ws + WS_NG))
#define MR ((bf16_t*)(ws + WS_MR))
#define MN ((bf16_t*)(ws + WS_MN))
#define KVS ((float*)(ws + WS_KVS))
#define PREV ((bf16_t*)(ws + WS_PREV))
#define YRET ((bf16_t*)(ws + WS_YRET))
#define YNSA ((bf16_t*)(ws + WS_YNSA))
#define T1 ((bf16_t*)(ws + WS_T1))
#define MG ((bf16_t*)(ws + WS_MG))
    {
        PHASE_IDS;
        LAS float* cond = (LAS float*)lds;
        LAS float* red = (LAS float*)(lds + 32768);
        bool have_cond = false;
        for (int it = blk; it < 96; it += G) {
            if (!have_cond) { for (int i = tid; i < 8 * 1024; i += NTHREADS) cond[i] = siluf_(cvec[i]); __syncthreads(); have_cond = true; }
            const int col = it * 64 + lane;
            float accb[8];
#pragma unroll
            for (int b = 0; b < 8; ++b) accb[b] = 0.f;
            const int kbeg = wave * 128;
#pragma unroll 8
            for (int k = kbeg; k < kbeg + 128; ++k) { const float wv = w_ada[(size_t)k * 6144 + col];
#pragma unroll
                for (int b = 0; b < 8; ++b) accb[b] += cond[b * 1024 + k] * wv; }
#pragma unroll
            for (int b = 0; b < 8; ++b) red[(wave * 8 + b) * 64 + lane] = accb[b];
            __syncthreads();
            { const int b = tid >> 6; float s = 0.f;
#pragma unroll
              for (int w = 0; w < 8; ++w) s += red[(w * 8 + b) * 64 + lane];
              MOD[b * 6144 + it * 64 + lane] = s + b_ada[it * 64 + lane]; }
            __syncthreads();
        }
        __syncthreads();
        LAS float* scr = (LAS float*)(lds + wave * 16384);
        constexpr int I_IN = 16 * 201, I_RET = 16 * 32, I_NSA = 8 * 32, I_OUT = 16 * 32, I_RT = 16 * 8, I_CMP = 32 * 2;
        for (int it = gw; it < I_IN + I_RET + I_NSA + I_OUT + I_RT + 2 * I_CMP; it += NGW) {
            int r = it;
            if (r < I_IN) { transpose_item(w_in, 1024, DIN, WIN, 1024, RowInProj{}, scr, r, lane); continue; } r -= I_IN;
            if (r < I_RET) { transpose_item(w_ret_out, 1024, 1024, WRET, 1024, RowId{0}, scr, r, lane); continue; } r -= I_RET;
            if (r < I_NSA) { transpose_item(w_nsa_out, 512, 1024, WNSA, 512, RowId{0}, scr, r, lane); continue; } r -= I_NSA;
            if (r < I_OUT) { transpose_item(w_out, 1024, 1024, WOUT, 1024, RowId{0}, scr, r, lane); continue; } r -= I_OUT;
            if (r < I_RT) { transpose_item(w_router, 1024, 256, WRT, 1024, RowId{0}, scr, r, lane); continue; } r -= I_RT;
            if (r < I_CMP) { transpose_item(w_cmp_k, 2048, 64, WCK, 2048, RowId{0}, scr, r, lane); continue; } r -= I_CMP;
            transpose_item(w_cmp_v, 2048, 64, WCV, 2048, RowId{0}, scr, r, lane);
        }
        if (gw < 2) {
            const float* pos = gw ? cmp_pos_v : cmp_pos_k; const float* wc_ = gw ? w_cmp_v : w_cmp_k; float sacc = 0.f;
            for (int k = 0; k < 2048; ++k) sacc += pos[k] * wc_[k * 64 + lane];
            CBIAS[gw * 64 + lane] = sacc;
        }
    }
    grid.sync();

    { PHASE_IDS;
    for (int m = gw; m < NTOK; m += NGW) {
        const int b = m / SEQ; const float* mod = MOD + b * 6144;
        const f32x4* xr = (const f32x4*)(X_IN + (size_t)m * DM) + lane;
        f32x4 v[4]; float s = 0.f;
#pragma unroll
        for (int j = 0; j < 4; ++j) { v[j] = xr[64 * j]; s += (v[j].x + v[j].y) + (v[j].z + v[j].w); }
        const float mean = wave_sum(s) * (1.f / DM); float s2 = 0.f;
#pragma unroll
        for (int j = 0; j < 4; ++j) { v[j] = v[j] - mean; s2 += (v[j].x * v[j].x + v[j].y * v[j].y) + (v[j].z * v[j].z + v[j].w * v[j].w); }
        const float rstd = 1.f / sqrtf(wave_sum(s2) * (1.f / DM) + LN_EPS);
        u32x2* o8 = (u32x2*)(Ub + (size_t)m * DM) + lane;
#pragma unroll
        for (int j = 0; j < 4; ++j) { const f32x4 sh = *((const f32x4*)(mod) + lane + 64 * j), sc = *((const f32x4*)(mod + 1024) + lane + 64 * j);
            const f32x4 hv = v[j] * rstd * (sc + 1.0f) + sh; u32x2 w; w.x = pk2(hv.x, hv.y); w.y = pk2(hv.z, hv.w); o8[64 * j] = w; }
    } }
    xcd_barrier(xbar);

    {
        pg8::Gemm g{Ub, WIN, 1024, nullptr}; pg8::StaticOrder S; S.init(NTOK, DIN_PAD, G, blk);
        pg8::EpiInProj E{ws};
        pg8::gemm_phase<pg8::EpiInProj, pg8::StaticOrder, false>(lds, g, S, E);
#if PROBE == 1
        pg8::gemm_phase<pg8::EpiInProj, pg8::StaticOrder, false>(lds, g, S, E);
#endif
    }
    xcd_barrier(xbar);

    for (int unit = blk; unit < 256; unit += G) nsa_cmp_unit(unit, KV6, WCK, CBIAS, KCMP, lds);
    for (int unit = blk; unit < 1024; unit += G) { if (((unit >> 2) & 31) == 31) continue; ret_kv_unit(unit, RK, RV, KVS, lds); }
    xcd_barrier(xbar);

    { PHASE_IDS;
    for (int idx8 = blk * NTHREADS + tid; idx8 < 131072; idx8 += G * NTHREADS) {
        const int bh = idx8 >> 12, b = bh >> 2, h = bh & 3; const size_t off = (size_t)(idx8 & 4095) * 8;
        const float dC = __builtin_amdgcn_exp2f(128.0f * ret_log2gamma(h));
        float st[8];
#pragma unroll
        for (int i = 0; i < 8; ++i) st[i] = 0.f;
        for (int n = 0; n < 32; ++n) { const size_t uo = (size_t)((b * 32 + n) * 4 + h) * 32768 + off;
            u32x4 w; w.x = pk2(st[0], st[1]); w.y = pk2(st[2], st[3]); w.z = pk2(st[4], st[5]); w.w = pk2(st[6], st[7]); *(u32x4*)(PREV + uo) = w;
            if (n < 31) { const f32x4 k0 = *(const f32x4*)(KVS + uo), k1 = *(const f32x4*)(KVS + uo + 4);
                st[0] = st[0] * dC + k0.x; st[1] = st[1] * dC + k0.y; st[2] = st[2] * dC + k0.z; st[3] = st[3] * dC + k0.w;
                st[4] = st[4] * dC + k1.x; st[5] = st[5] * dC + k1.y; st[6] = st[6] * dC + k1.z; st[7] = st[7] * dC + k1.w; } }
    } }
    xcd_barrier(xbar);

#if PROBE == 3
    for (int rep = 0; rep < 2; ++rep)
#endif
    for (int unit = blk; unit < 1024; unit += G) ret_out_unit(unit, RQ, RK, RV, RG, PREV, YRET, lds);
#if PROBE == 2
    for (int rep = 0; rep < 2; ++rep)
#endif
    { int it = 0; for (int idx = blk; idx < 1024; idx += G, ++it) { const int qb0 = (idx >> 1) & 63;
        nsa_attn_unit((idx & ~126) | (((it & 1) ? 63 - qb0 : qb0) << 1), NQ, KV6, KCMP, NG, YNSA, lds); } }
    xcd_barrier(xbar);

    {
        pg8::Gemm g{YRET, WRET, 1024, nullptr}; pg8::StaticOrder S; S.init(NTOK, 1024, G, blk);
        pg8::EpiGate E{T1, MR, nullptr};
        pg8::gemm_phase<pg8::EpiGate, pg8::StaticOrder, false>(lds, g, S, E);
    }
    {
        pg8::Gemm g{YNSA, WNSA, 512, nullptr}; pg8::StaticOrder S; S.init(NTOK, 1024, G, blk);
        pg8::EpiGate E{MG, MN, T1};
        pg8::gemm_phase<pg8::EpiGate, pg8::StaticOrder, false>(lds, g, S, E);
    }
    xcd_barrier(xbar);
    {
        pg8::Gemm g{MG, WOUT, 1024, nullptr}; pg8::StaticOrder S; S.init(NTOK, 1024, G, blk);
        pg8::EpiResid E{OUT_P, X_IN, MOD};
        pg8::gemm_phase<pg8::EpiResid, pg8::StaticOrder, false>(lds, g, S, E);
    }
    xcd_barrier(xbar);

    { PHASE_IDS;
    for (int m = gw; m < NTOK; m += NGW) {
        const int b = m / SEQ; const float* mod = MOD + b * 6144;
        const f32x4* xr = (const f32x4*)(OUT_P + (size_t)m * DM) + lane;
        f32x4 v[4]; float s = 0.f;
#pragma unroll
        for (int j = 0; j < 4; ++j) { v[j] = xr[64 * j]; s += (v[j].x + v[j].y) + (v[j].z + v[j].w); }
        float mean = wave_sum(s) * (1.f / DM); float s2 = 0.f;
#pragma unroll
        for (int j = 0; j < 4; ++j) { v[j] = v[j] - mean; s2 += (v[j].x * v[j].x + v[j].y * v[j].y) + (v[j].z * v[j].z + v[j].w * v[j].w); }
        float rstd = 1.f / sqrtf(wave_sum(s2) * (1.f / DM) + LN_EPS);
        s = 0.f;
#pragma unroll
        for (int j = 0; j < 4; ++j) { const f32x4 gg = *((const f32x4*)ln1_g + lane + 64 * j), bb = *((const f32x4*)ln1_b + lane + 64 * j);
            v[j] = v[j] * rstd * gg + bb; *((f32x4*)(OUT_P + (size_t)m * DM) + lane + 64 * j) = v[j]; s += (v[j].x + v[j].y) + (v[j].z + v[j].w); }
        mean = wave_sum(s) * (1.f / DM); s2 = 0.f;
#pragma unroll
        for (int j = 0; j < 4; ++j) { v[j] = v[j] - mean; s2 += (v[j].x * v[j].x + v[j].y * v[j].y) + (v[j].z * v[j].z + v[j].w * v[j].w); }
        rstd = 1.f / sqrtf(wave_sum(s2) * (1.f / DM) + LN_EPS);
        u32x2* o8 = (u32x2*)(Hb + (size_t)m * DM) + lane;
#pragma unroll
        for (int j = 0; j < 4; ++j) { const f32x4 sh = *((const f32x4*)(mod + 3 * 1024) + lane + 64 * j), sc = *((const f32x4*)(mod + 4 * 1024) + lane + 64 * j);
            const f32x4 hv = v[j] * rstd * (sc + 1.0f) + sh; u32x2 w; w.x = pk2(hv.x, hv.y); w.y = pk2(hv.z, hv.w); o8[64 * j] = w; }
    } }
    xcd_barrier(xbar);

    {
        pg8::Gemm g{Hb, WRT, 1024, nullptr}; pg8::StaticOrder S; S.init(NTOK, 256, G, blk);
        pg8::EpiF32 E{LOGITS, 256};
        pg8::gemm_phase<pg8::EpiF32, pg8::StaticOrder, false>(lds, g, S, E);
        __syncthreads();
        PHASE_IDS;
        LAS float* scr = (LAS float*)(lds + wave * 16384);
        constexpr int I13 = 16 * 8, I2 = 4 * 32;
#if PROBE == 4
        for (int rep = 0; rep < 2; ++rep)
#endif
        for (int it = gw; it < 257 * (2 * I13 + I2); it += NGW) {
            const int ex = it / (2 * I13 + I2); int r = it % (2 * I13 + I2);
            if (r < I13) { transpose_item(ex < 256 ? w_e1 + (size_t)ex * 1024 * 256 : w_s1, 1024, 256, E13, 1024, RowE13{ex, 0}, scr, r, lane); continue; } r -= I13;
            if (r < I13) { transpose_item(ex < 256 ? w_e3 + (size_t)ex * 1024 * 256 : w_s3, 1024, 256, E13, 1024, RowE13{ex, 1}, scr, r, lane); continue; } r -= I13;
            transpose_item(ex < 256 ? w_e2 + (size_t)ex * 256 * 1024 : w_s2, 256, 1024, E2, 256, RowId{ex * 1024}, scr, r, lane);
        }
    }
    xcd_barrier(xbar);

    {
        PHASE_IDS;
        LAS unsigned* cntl = (LAS unsigned*)lds;
        for (int tb = blk; tb < NTOK / 128; tb += G) {
            if (tid < 256) cntl[tid] = 0u;
            __syncthreads();
            for (int tl = wave; tl < 128; tl += NWAVES) {
                const int tok = tb * 128 + tl;
                const f32x4 lg = *((const f32x4*)(LOGITS + (size_t)tok * 256) + lane);
                const f32x4 br = *((const f32x4*)b_router + lane);
                float sv[4];
                sv[0] = sigmoidf_(lg.x) + br.x; sv[1] = sigmoidf_(lg.y) + br.y; sv[2] = sigmoidf_(lg.z) + br.z; sv[3] = sigmoidf_(lg.w) + br.w;
                float m1 = fmaxf(sv[0], sv[1]), m2 = fminf(sv[0], sv[1]);
                { const float c = sv[2]; const float n1 = fmaxf(m1, c); m2 = fmaxf(fminf(m1, c), m2); m1 = n1; }
                { const float c = sv[3]; const float n1 = fmaxf(m1, c); m2 = fmaxf(fminf(m1, c), m2); m1 = n1; }
#pragma unroll
                for (int o = 1; o < 8; o <<= 1) { const float o1 = __shfl_xor(m1, o), o2 = __shfl_xor(m2, o); const float n1 = fmaxf(m1, o1); m2 = fmaxf(fminf(m1, o1), fmaxf(m2, o2)); m1 = n1; }
                const float gs = m1 + m2; const int myg = lane >> 3; int rank = 0;
#pragma unroll
                for (int gq = 0; gq < 8; ++gq) { const float og = __shfl(gs, gq * 8); rank += (og > gs || (og == gs && gq < myg)) ? 1 : 0; }
                const bool keep = rank < 4;
                unsigned long long key[4];
#pragma unroll
                for (int i = 0; i < 4; ++i) { const float sc = keep ? sv[i] : -1.0e30f; unsigned ub = __builtin_bit_cast(unsigned, sc); ub = (ub & 0x80000000u) ? ~ub : (ub | 0x80000000u);
                    key[i] = ((unsigned long long)ub << 8) | (unsigned long long)(255 - (lane * 4 + i)); }
                int my_e = 0;
#pragma unroll 1
                for (int k = 0; k < TOPK; ++k) {
                    unsigned long long best = key[0]; best = key[1] > best ? key[1] : best; best = key[2] > best ? key[2] : best; best = key[3] > best ? key[3] : best;
#pragma unroll
                    for (int o = 1; o < 64; o <<= 1) { const unsigned lo = __shfl_xor((unsigned)best, o), hi = __shfl_xor((unsigned)(best >> 32), o);
                        const unsigned long long ob = ((unsigned long long)hi << 32) | lo; best = ob > best ? ob : best; }
                    const int e = 255 - (int)(best & 0xffull);
                    if (lane == k) my_e = e;
#pragma unroll
                    for (int i = 0; i < 4; ++i) if (lane * 4 + i == e) key[i] = 0ull;
                }
                float aff = 0.f;
                if (lane < TOPK) aff = sigmoidf_(LOGITS[(size_t)tok * 256 + my_e]);
                float asum = aff;
#pragma unroll
                for (int o = 1; o < 8; o <<= 1) asum += __shfl_xor(asum, o);
                if (lane < TOPK) {
                    const unsigned lr = __hip_atomic_fetch_add(cntl + my_e, 1u, __ATOMIC_RELAXED, __HIP_MEMORY_SCOPE_WORKGROUP);
                    EIDX[tok * 8 + lane] = my_e; WSEL[tok * 8 + lane] = aff / asum * ROUTED_SCALE; LRANK[tok * 8 + lane] = (int)lr;
                }
            }
            __syncthreads();
            if (tid < 256) BBASE[tb * 256 + tid] = (int)atomicAdd(ctl + tid, cntl[tid]);
            __syncthreads();
        }
    }
    xcd_barrier(xbar);

    {
        PHASE_IDS;
        LAS int* pad = (LAS int*)lds; LAS int* ps = (LAS int*)(lds + 1024); LAS int* cn = (LAS int*)(lds + 2048);
        if (tid < 256) { const int c = (int)__hip_atomic_load(ctl + tid, __ATOMIC_RELAXED, __HIP_MEMORY_SCOPE_AGENT); cn[tid] = c; pad[tid] = (c + 255) & ~255; }
        __syncthreads();
        if (tid < 256) { int s = 0; for (int j = 0; j < tid; ++j) s += pad[j]; ps[tid] = s; }
        __syncthreads();
        const int p_routed = ps[255] + pad[255];
        for (int tb = blk; tb < NTOK / 128; tb += G) {
            for (int aidx = tid; aidx < 1024; aidx += NTHREADS) { const int tok = tb * 128 + (aidx >> 3), k = aidx & 7; const int e = EIDX[tok * 8 + k];
                const int slot = ps[e] + BBASE[tb * 256 + e] + LRANK[tok * 8 + k]; ROWTOK[slot] = tok; DEST[slot] = tok * 9 + k; }
            if (tid < 128) { const int tok = tb * 128 + tid; ROWTOK[p_routed + tok] = tok; DEST[p_routed + tok] = tok * 9 + 8; }
        }
        for (int e = blk; e < NEXP; e += G) {
            for (int r = cn[e] + tid; r < pad[e]; r += NTHREADS) { ROWTOK[ps[e] + r] = 0; DEST[ps[e] + r] = -1; }
            for (int j = tid; j < pad[e] / 256; j += NTHREADS) TILEE[ps[e] / 256 + j] = e;
        }
        for (int j = blk * NTHREADS + tid; j < NTOK / 256; j += G * NTHREADS) TILEE[p_routed / 256 + j] = 256;
        if (blk == 0 && tid == 0) ctl[256] = (unsigned)(p_routed / 256 + NTOK / 256);
        __syncthreads();
    }
    xcd_barrier(xbar);

    const int ntiles = (int)__hip_atomic_load(ctl + 256, __ATOMIC_RELAXED, __HIP_MEMORY_SCOPE_AGENT);
    {
        pg8::Gemm g{Hb, E13, 1024, ROWTOK}; pg8::MoeOrder S{TILEE, ntiles, 2, G, blk};
        pg8::EpiSwiGlu E{Gb};
        pg8::gemm_phase<pg8::EpiSwiGlu, pg8::MoeOrder, true>(lds, g, S, E);
#if PROBE == 5
        pg8::gemm_phase<pg8::EpiSwiGlu, pg8::MoeOrder, true>(lds, g, S, E);
#endif
    }
    xcd_barrier(xbar);
    {
        pg8::Gemm g{Gb, E2, 256, nullptr}; pg8::MoeOrder S{TILEE, ntiles, 4, G, blk};
        pg8::EpiScatter E{Yb, DEST};
        pg8::gemm_phase<pg8::EpiScatter, pg8::MoeOrder, false>(lds, g, S, E);
#if PROBE == 6
        pg8::gemm_phase<pg8::EpiScatter, pg8::MoeOrder, false>(lds, g, S, E);
#endif
    }
    xcd_barrier(xbar);

    { PHASE_IDS;
    for (int m = gw; m < NTOK; m += NGW) {
        const int b = m / SEQ; const float* mod = MOD + b * 6144;
        float wk[8];
#pragma unroll
        for (int k = 0; k < 8; ++k) wk[k] = WSEL[m * 8 + k];
        f32x4 v[4]; float s = 0.f;
#pragma unroll
        for (int j = 0; j < 4; ++j) {
            f32x4 y = (f32x4){0.f, 0.f, 0.f, 0.f};
#pragma unroll
            for (int k = 0; k < 9; ++k) { const u32x2 w = *((const u32x2*)(Yb + ((size_t)m * 9 + k) * DM) + lane + 64 * j); const float wt = (k < 8) ? wk[k & 7] : 1.0f;
                y.x += wt * bf_lo(w.x); y.y += wt * bf_hi(w.x); y.z += wt * bf_lo(w.y); y.w += wt * bf_hi(w.y); }
            const f32x4 g2 = *((const f32x4*)(mod + 5 * 1024) + lane + 64 * j);
            const f32x4 x1 = *((const f32x4*)(OUT_P + (size_t)m * DM) + lane + 64 * j);
            v[j] = x1 * ALPHA + (g2 + 1.0f) * y; s += (v[j].x + v[j].y) + (v[j].z + v[j].w);
        }
        const float mean = wave_sum(s) * (1.f / DM); float s2 = 0.f;
#pragma unroll
        for (int j = 0; j < 4; ++j) { v[j] = v[j] - mean; s2 += (v[j].x * v[j].x + v[j].y * v[j].y) + (v[j].z * v[j].z + v[j].w * v[j].w); }
        const float rstd = 1.f / sqrtf(wave_sum(s2) * (1.f / DM) + LN_EPS);
#pragma unroll
        for (int j = 0; j < 4; ++j) { const f32x4 gg = *((const f32x4*)ln2_g + lane + 64 * j), bb = *((const f32x4*)ln2_b + lane + 64 * j);
            *((f32x4*)(OUT_P + (size_t)m * DM) + lane + 64 * j) = v[j] * rstd * gg + bb; }
    } }
}

#undef ws
#undef X_IN
#undef cvec
#undef w_ada
#undef b_ada
#undef w_in
#undef cmp_pos_k
#undef cmp_pos_v
#undef w_cmp_k
#undef w_cmp_v
#undef w_ret_out
#undef w_nsa_out
#undef w_out
#undef ln1_g
#undef ln1_b
#undef w_router
#undef b_router
#undef w_e1
#undef w_e3
#undef w_e2
#undef w_s1
#undef w_s3
#undef w_s2
#undef ln2_g
#undef ln2_b
#undef OUT_P
#undef ctl
#undef MOD
#undef WRT
#undef E13
#undef E2
#undef Hb
#undef LOGITS
#undef EIDX
#undef WSEL
#undef LRANK
#undef BBASE
#undef ROWTOK
#undef DEST
#undef TILEE
#undef Gb
#undef Yb
#undef WIN
#undef WRET
#undef WNSA
#undef WOUT
#undef WCK
#undef WCV
#undef KCMP
#undef CBIAS
#undef Ub
#undef RQ
#undef RK
#undef RV
#undef RG
#undef NQ
#undef KV6
#undef NG
#undef MR
#undef MN
#undef KVS
#undef PREV
#undef YRET
#undef YNSA
#undef T1
#undef MG
extern "C" void kernel_launch(void* const* d_in, const int* in_sizes, int n_in, void* d_out, int out_size, void* d_ws, size_t ws_size, hipStream_t stream) {
    static int grid = 0;
    if (grid == 0) {
        if (n_in != 24 || out_size != NTOK * DM || ws_size < WS_END) { fprintf(stderr, "kernel_launch: unexpected shapes (n_in %d out %d ws %zu, need ws >= %zu)\n", n_in, out_size, ws_size, (size_t)WS_END); grid = -1; return; }
        int dev = 0, cus = 0, per_cu = 0;
        hipGetDevice(&dev);
        hipDeviceGetAttribute(&cus, hipDeviceAttributeMultiprocessorCount, dev);
        if (hipFuncSetAttribute((const void*)mega_fwd, hipFuncAttributeMaxDynamicSharedMemorySize, LDS_BYTES) != hipSuccess) { fprintf(stderr, "kernel_launch: hipFuncSetAttribute failed\n"); grid = -1; return; }
        if (hipOccupancyMaxActiveBlocksPerMultiprocessor(&per_cu, (const void*)mega_fwd, NTHREADS, LDS_BYTES) != hipSuccess || per_cu < 1) { fprintf(stderr, "kernel_launch: occupancy query says %d blocks per CU\n", per_cu); grid = -1; return; }
        grid = cus;
    }
    if (grid < 0) return;
    hipMemsetAsync((char*)d_ws + WS_CTL, 0, CTL_BYTES, stream);
    Args a{};
    for (int i = 0; i < 24; ++i) a.in[i] = (const float*)d_in[i];
    a.out = (float*)d_out; a.ws = (unsigned char*)d_ws;
    void* args[] = {&a};
    hipError_t e = hipLaunchCooperativeKernel((const void*)mega_fwd, dim3(grid), dim3(NTHREADS), args, LDS_BYTES, stream);
    if (e != hipSuccess) fprintf(stderr, "kernel_launch: cooperative launch failed: %s (grid %d)\n", hipGetErrorString(e), grid);
}
```
